# Optimizing an MI355X kernel written in HIP

```python
import math
import jax, jax.numpy as jnp
from jax import lax
import numpy as np

D_MODEL = 1024
BATCH = 8
SEQ = 4096
DEPTH = 2

EPS = 1e-6
D_FF = 2752
PLE_DIM = 256

S5_WIDTH = 512
S5_GROUP = 16
S5_GROUPS = S5_WIDTH // S5_GROUP
S5_STATE = 64

GLA_HEADS = 4
GLA_DK = 64
GLA_DV = 128
GLA_KEY = GLA_HEADS * GLA_DK
GLA_VAL = GLA_HEADS * GLA_DV
GLA_RANK = 16
GLA_GATE_NORM = 16.0
GLA_CHUNK = 64

SSD_HEADS = 8
SSD_HEADDIM = 64
SSD_INNER = SSD_HEADS * SSD_HEADDIM
SSD_GROUPS = 2
SSD_STATE = 128
SSD_CONV = 4
SSD_CHUNK = 128
SSD_CONV_DIM = SSD_INNER + 2 * SSD_GROUPS * SSD_STATE

N_BRANCH = 3
IN_SIZES = (S5_WIDTH, GLA_KEY, GLA_KEY, GLA_VAL, GLA_VAL, GLA_RANK,
            SSD_INNER, SSD_CONV_DIM, SSD_HEADS, D_MODEL, D_MODEL, D_MODEL)
IN_TOTAL = sum(IN_SIZES)

kernel_name = "hybrid_s5_gla_ssd_gated_macaron"


def rmsnorm(x, w):
    xf = x.astype(jnp.float32)
    r = lax.rsqrt(jnp.mean(xf * xf, axis=-1, keepdims=True) + EPS)
    return (xf * r * w.astype(jnp.float32)).astype(x.dtype)


def swiglu(x, w_gate, w_up, w_down):
    return (jax.nn.silu(x @ w_gate) * (x @ w_up)) @ w_down


def _cplx_combine(e1, e2):
    ar1, ai1, br1, bi1 = e1
    ar2, ai2, br2, bi2 = e2
    return (ar1 * ar2 - ai1 * ai2,
            ar1 * ai2 + ai1 * ar2,
            ar2 * br1 - ai2 * bi1 + br2,
            ar2 * bi1 + ai2 * br1 + bi2)


def s5_mixer(u, lam_re, lam_im, log_step, b_re, b_im, c_re, c_im, d_skip, w_glu):
    bsz, s, _ = u.shape
    uf = u.astype(jnp.float32)
    ug = uf.reshape(bsz, s, S5_GROUPS, S5_GROUP)
    lr = jnp.minimum(lam_re.astype(jnp.float32), -1e-4)
    li = lam_im.astype(jnp.float32)
    step = jnp.exp(log_step.astype(jnp.float32))[:, None]
    mag = jnp.exp(lr * step)
    ar = mag * jnp.cos(li * step)
    ai = mag * jnp.sin(li * step)
    den = lr * lr + li * li
    nr = ar - 1.0
    fr = (nr * lr + ai * li) / den
    fi = (ai * lr - nr * li) / den
    br = b_re.astype(jnp.float32)
    bi = b_im.astype(jnp.float32)
    bbr = fr[..., None] * br - fi[..., None] * bi
    bbi = fr[..., None] * bi + fi[..., None] * br
    xr = jnp.einsum('bsgh,gph->sbgp', ug, bbr)
    xi = jnp.einsum('bsgh,gph->sbgp', ug, bbi)
    a_r = jnp.broadcast_to(ar[None, None], (s, 1) + ar.shape)
    a_i = jnp.broadcast_to(ai[None, None], (s, 1) + ai.shape)
    _, _, hr, hi = lax.associative_scan(_cplx_combine, (a_r, a_i, xr, xi), axis=0)
    y = (jnp.einsum('sbgp,ghp->bsgh', hr, c_re.astype(jnp.float32))
         - jnp.einsum('sbgp,ghp->bsgh', hi, c_im.astype(jnp.float32)))
    y = y.reshape(bsz, s, S5_WIDTH) + d_skip.astype(jnp.float32) * uf
    g = jax.nn.gelu(y).astype(u.dtype)
    return g * jax.nn.sigmoid(g @ w_glu)


def _gla_chunk(state, inp):
    qc, kc, vc, bc = inp
    n = qc.shape[2]
    causal = jnp.tril(jnp.ones((n, n), dtype=bool))
    inter = jnp.einsum('bhik,bhkv->bhiv', qc * jnp.exp(bc), state)
    diff = bc[:, :, :, None, :] - bc[:, :, None, :, :]
    decay = jnp.exp(jnp.where(causal[:, :, None], diff, -jnp.inf))
    attn = jnp.einsum('bhijk,bhjk->bhij', qc[:, :, :, None, :] * decay, kc)
    intra = jnp.einsum('bhij,bhjv->bhiv', attn, vc)
    b_last = bc[:, :, -1:, :]
    new_state = (jnp.exp(b_last[:, :, 0, :])[..., None] * state
                 + jnp.einsum('bhjk,bhjv->bhkv', kc * jnp.exp(b_last - bc), vc))
    return new_state, inter + intra


def gla_mixer(q, k, v, g_out, gate_lr, w_gate2, b_gate2, norm_w):
    bsz, s, _ = q.shape
    nc = s // GLA_CHUNK
    log_a = jax.nn.log_sigmoid((gate_lr @ w_gate2 + b_gate2).astype(jnp.float32)) / GLA_GATE_NORM

    def to_chunks(t, d):
        t = t.astype(jnp.float32).reshape(bsz, nc, GLA_CHUNK, GLA_HEADS, d)
        return t.transpose(1, 0, 3, 2, 4)

    qc = to_chunks(q, GLA_DK) * (GLA_DK ** -0.5)
    kc = to_chunks(k, GLA_DK)
    vc = to_chunks(v, GLA_DV)
    bc = jnp.cumsum(to_chunks(log_a, GLA_DK), axis=3)
    state0 = jnp.zeros((bsz, GLA_HEADS, GLA_DK, GLA_DV), jnp.float32)
    _, o = lax.scan(_gla_chunk, state0, (qc, kc, vc, bc))
    o = o.transpose(1, 0, 3, 2, 4).reshape(bsz, s, GLA_HEADS, GLA_DV)
    o = rmsnorm(o, norm_w).reshape(bsz, s, GLA_VAL)
    return (o * jax.nn.silu(g_out.astype(jnp.float32))).astype(q.dtype)


def causal_dwconv(x, w, b):
    c = x.shape[-1]
    out = lax.conv_general_dilated(x, w[:, None, :], window_strides=(1,),
                                   padding=((SSD_CONV - 1, 0),),
                                   dimension_numbers=('NWC', 'WIO', 'NWC'),
                                   feature_group_count=c)
    return out + b


def _ssd_chunk_state(h, inp):
    da, st = inp
    return jnp.exp(da)[..., None, None] * h + st, h


def ssd_mixer(z, xbc, dt_raw, conv_w, conv_b, dt_bias, a_log, d_skip, norm_w):
    bsz, s, _ = z.shape
    nc = s // SSD_CHUNK
    rep = SSD_HEADS // SSD_GROUPS
    xbc = jax.nn.silu(causal_dwconv(xbc, conv_w, conv_b)).astype(jnp.float32)
    xs = xbc[..., :SSD_INNER].reshape(bsz, s, SSD_HEADS, SSD_HEADDIM)
    bm = xbc[..., SSD_INNER:SSD_INNER + SSD_GROUPS * SSD_STATE].reshape(bsz, nc, SSD_CHUNK, SSD_GROUPS, SSD_STATE)
    cm = xbc[..., SSD_INNER + SSD_GROUPS * SSD_STATE:].reshape(bsz, nc, SSD_CHUNK, SSD_GROUPS, SSD_STATE)
    dt = jax.nn.softplus((dt_raw + dt_bias).astype(jnp.float32))
    a = -jnp.exp(a_log.astype(jnp.float32))
    la = (dt * a).reshape(bsz, nc, SSD_CHUNK, SSD_GROUPS, rep)
    xdt = (xs * dt[..., None]).reshape(bsz, nc, SSD_CHUNK, SSD_GROUPS, rep, SSD_HEADDIM)
    cum = jnp.cumsum(la, axis=2)
    causal = jnp.tril(jnp.ones((SSD_CHUNK, SSD_CHUNK), dtype=bool))
    diff = cum[:, :, :, None] - cum[:, :, None, :]
    decay = jnp.exp(jnp.where(causal[:, :, None, None], diff, -jnp.inf))
    scores = jnp.einsum('bclgn,bcmgn->bclmg', cm, bm)
    y_diag = jnp.einsum('bclmgr,bcmgrp->bclgrp', scores[..., None] * decay, xdt)
    decay_states = jnp.exp(cum[:, :, -1:] - cum)
    states = jnp.einsum('bclgn,bclgr,bclgrp->bcgrpn', bm, decay_states, xdt)
    h0 = jnp.zeros((bsz, SSD_GROUPS, rep, SSD_HEADDIM, SSD_STATE), jnp.float32)
    _, h_in = lax.scan(_ssd_chunk_state, h0,
                       (cum[:, :, -1].transpose(1, 0, 2, 3), states.transpose(1, 0, 2, 3, 4, 5)))
    h_in = h_in.transpose(1, 0, 2, 3, 4, 5)
    y_off = jnp.einsum('bclgn,bcgrpn,bclgr->bclgrp', cm, h_in, jnp.exp(cum))
    y = (y_diag + y_off).reshape(bsz, s, SSD_HEADS, SSD_HEADDIM)
    y = y + d_skip.astype(jnp.float32)[:, None] * xs
    y = y.reshape(bsz, s, SSD_INNER) * jax.nn.silu(z.astype(jnp.float32))
    y = rmsnorm(y.reshape(bsz, s, SSD_GROUPS, SSD_INNER // SSD_GROUPS),
                norm_w.reshape(SSD_GROUPS, SSD_INNER // SSD_GROUPS))
    return y.reshape(bsz, s, SSD_INNER).astype(z.dtype)


def hybrid_mix(u, w_in, s5_lam_re, s5_lam_im, s5_log_step, s5_b_re, s5_b_im, s5_c_re, s5_c_im,
               s5_d, s5_glu, gla_gate_w2, gla_gate_b2, gla_norm, ssd_conv_w, ssd_conv_b,
               ssd_dt_bias, ssd_a_log, ssd_d, ssd_norm, w_br_s5, w_br_gla, w_br_ssd, w_out):
    split_pts = np.cumsum(IN_SIZES)[:-1].tolist()
    (u_s5, q, k, v, g_out, gate_lr, z, xbc, dt_raw,
     gate_s5, gate_gla, gate_ssd) = jnp.split(u @ w_in, split_pts, axis=-1)
    y_s5 = s5_mixer(u_s5, s5_lam_re, s5_lam_im, s5_log_step, s5_b_re, s5_b_im,
                    s5_c_re, s5_c_im, s5_d, s5_glu)
    y_gla = gla_mixer(q, k, v, g_out, gate_lr, gla_gate_w2, gla_gate_b2, gla_norm)
    y_ssd = ssd_mixer(z, xbc, dt_raw, ssd_conv_w, ssd_conv_b, ssd_dt_bias, ssd_a_log, ssd_d, ssd_norm)
    merged = (jax.nn.sigmoid(gate_s5) * (y_s5 @ w_br_s5)
              + jax.nn.sigmoid(gate_gla) * (y_gla @ w_br_gla)
              + jax.nn.sigmoid(gate_ssd) * (y_ssd @ w_br_ssd))
    return merged @ w_out


def setup_inputs(seed: int = 0) -> dict:
    key = jax.random.key(seed)
    ks = iter(jax.random.split(key, 48))
    L = DEPTH

    def nrm(shape, scale):
        return jax.random.normal(next(ks), shape, jnp.float32) * scale

    def gain(shape):
        return 1.0 + nrm(shape, 0.01)

    def unif(shape, lo, hi):
        return jax.random.uniform(next(ks), shape, jnp.float32, lo, hi)

    n_idx = jnp.arange(S5_STATE, dtype=jnp.float32)
    dt_init = jnp.exp(unif((L, SSD_HEADS), math.log(1e-3), math.log(1e-1)))
    return {
        "x": nrm((BATCH, SEQ, D_MODEL), 1.0),
        "p": nrm((DEPTH, BATCH, SEQ, PLE_DIM), 1.0),
        "ffn1_norm": gain((L, D_MODEL)),
        "ffn1_gate": nrm((L, D_MODEL, D_FF), D_MODEL ** -0.5),
        "ffn1_up": nrm((L, D_MODEL, D_FF), D_MODEL ** -0.5),
        "ffn1_down": nrm((L, D_FF, D_MODEL), D_FF ** -0.5),
        "mix_norm": gain((L, D_MODEL)),
        "w_in": nrm((L, D_MODEL, IN_TOTAL), D_MODEL ** -0.5),
        "s5_lam_re": -0.5 + nrm((L, S5_GROUPS, S5_STATE), 0.01),
        "s5_lam_im": math.pi * n_idx + nrm((L, S5_GROUPS, S5_STATE), 0.01),
        "s5_log_step": unif((L, S5_GROUPS), math.log(1e-3), math.log(1e-1)),
        "s5_b_re": nrm((L, S5_GROUPS, S5_STATE, S5_GROUP), (2.0 * S5_GROUP) ** -0.5),
        "s5_b_im": nrm((L, S5_GROUPS, S5_STATE, S5_GROUP), (2.0 * S5_GROUP) ** -0.5),
        "s5_c_re": nrm((L, S5_GROUPS, S5_GROUP, S5_STATE), S5_STATE ** -0.5),
        "s5_c_im": nrm((L, S5_GROUPS, S5_GROUP, S5_STATE), S5_STATE ** -0.5),
        "s5_d": nrm((L, S5_WIDTH), 1.0),
        "s5_glu": nrm((L, S5_WIDTH, S5_WIDTH), S5_WIDTH ** -0.5),
        "gla_gate_w2": nrm((L, GLA_RANK, GLA_KEY), GLA_RANK ** -0.5),
        "gla_gate_b2": nrm((L, GLA_KEY), 0.1),
        "gla_norm": gain((L, GLA_DV)),
        "ssd_conv_w": nrm((L, SSD_CONV, SSD_CONV_DIM), SSD_CONV ** -0.5),
        "ssd_conv_b": nrm((L, SSD_CONV_DIM), 0.01),
        "ssd_dt_bias": dt_init + jnp.log(-jnp.expm1(-dt_init)),
        "ssd_a_log": jnp.log(unif((L, SSD_HEADS), 1.0, 16.0)),
        "ssd_d": gain((L, SSD_HEADS)),
        "ssd_norm": gain((L, SSD_INNER)),
        "w_br_s5": nrm((L, S5_WIDTH, D_MODEL), S5_WIDTH ** -0.5),
        "w_br_gla": nrm((L, GLA_VAL, D_MODEL), GLA_VAL ** -0.5),
        "w_br_ssd": nrm((L, SSD_INNER, D_MODEL), SSD_INNER ** -0.5),
        "w_out": nrm((L, D_MODEL, D_MODEL), D_MODEL ** -0.5),
        "ffn2_norm": gain((L, D_MODEL)),
        "ffn2_gate": nrm((L, D_MODEL, D_FF), D_MODEL ** -0.5),
        "ffn2_up": nrm((L, D_MODEL, D_FF), D_MODEL ** -0.5),
        "ffn2_down": nrm((L, D_FF, D_MODEL), D_FF ** -0.5),
        "ple_norm": gain((L, D_MODEL)),
        "ple_gate": nrm((L, D_MODEL, D_MODEL), D_MODEL ** -0.5),
        "ple_proj": nrm((L, PLE_DIM, D_MODEL), PLE_DIM ** -0.5),
        "final_norm": gain((D_MODEL,)),
    }


def reference(x, p, ffn1_norm, ffn1_gate, ffn1_up, ffn1_down, mix_norm, w_in,
              s5_lam_re, s5_lam_im, s5_log_step, s5_b_re, s5_b_im, s5_c_re, s5_c_im, s5_d, s5_glu,
              gla_gate_w2, gla_gate_b2, gla_norm, ssd_conv_w, ssd_conv_b, ssd_dt_bias, ssd_a_log,
              ssd_d, ssd_norm, w_br_s5, w_br_gla, w_br_ssd, w_out, ffn2_norm, ffn2_gate, ffn2_up,
              ffn2_down, ple_norm, ple_gate, ple_proj, final_norm):
    h = x
    for i in range(DEPTH):
        h = h + 0.5 * swiglu(rmsnorm(h, ffn1_norm[i]), ffn1_gate[i], ffn1_up[i], ffn1_down[i])
        h = h + hybrid_mix(rmsnorm(h, mix_norm[i]), w_in[i],
                           s5_lam_re[i], s5_lam_im[i], s5_log_step[i], s5_b_re[i], s5_b_im[i],
                           s5_c_re[i], s5_c_im[i], s5_d[i], s5_glu[i],
                           gla_gate_w2[i], gla_gate_b2[i], gla_norm[i],
                           ssd_conv_w[i], ssd_conv_b[i], ssd_dt_bias[i], ssd_a_log[i], ssd_d[i], ssd_norm[i],
                           w_br_s5[i], w_br_gla[i], w_br_ssd[i], w_out[i])
        h = h + 0.5 * swiglu(rmsnorm(h, ffn2_norm[i]), ffn2_gate[i], ffn2_up[i], ffn2_down[i])
        h = h + jax.nn.sigmoid(rmsnorm(h, ple_norm[i]) @ ple_gate[i]) * (p[i] @ ple_proj[i])
    return rmsnorm(h, final_norm)
```

```cpp
#ifndef CPU_EMU
#include <hip/hip_runtime.h>
#include <hip/hip_cooperative_groups.h>
namespace cg = cooperative_groups;
#define DEV __device__ __forceinline__
#define SYNC() __syncthreads()
#else
#include <cmath>
#include <cstring>
#include <cstdio>
#include <cstdlib>
#define DEV inline
#define SYNC() do {} while (0)
#endif

typedef unsigned short bf16_t;

#ifndef EMU_BATCH
#define EMU_BATCH 8
#define EMU_SEQ 4096
#endif
constexpr int BATCH = EMU_BATCH, SEQ = EMU_SEQ, DEPTH = 2;
constexpr int D = 1024, DFF = 2752, DFFP = 2816, NGU = 5632, PLE = 256;
constexpr int T = BATCH * SEQ, TH = T / 2, SEQH = BATCH / 2;
constexpr int NC64 = SEQ / 64, NC128 = SEQ / 128, NCH16 = SEQ / 16, CHH = TH / 16;
constexpr int PROJ_LD = 3072, IN_N = 3840, IN_TOTAL = 6680;
constexpr int PC_Q = 0, PC_K = 256, PC_V = 512, PC_GO = 1024, PC_Z = 1536, PC_X = 2048;
constexpr float EPS = 1e-6f;

constexpr size_t al256(size_t x) { return (x + 255) & ~(size_t)255; }
constexpr size_t SZ_GU = (size_t)NGU * D * 2, SZ_DN = (size_t)D * DFFP * 2;
constexpr size_t W_GU1 = 0, W_D1 = W_GU1 + SZ_GU, W_GU2 = W_D1 + SZ_DN, W_D2 = W_GU2 + SZ_GU;
constexpr size_t W_IN = W_D2 + SZ_DN, W_G = W_IN + (size_t)IN_N * D * 2, W_GLU = W_G + (size_t)3072 * D * 2;
constexpr size_t W_BR = W_GLU + (size_t)512 * 512 * 2, W_OUT = W_BR + (size_t)3 * 1024 * 512 * 2, W_PG = W_OUT + (size_t)D * D * 2;
constexpr size_t W_PP = W_PG + (size_t)D * D * 2, W_S1 = W_PP + (size_t)D * PLE * 2, W_S3 = W_S1 + (size_t)32 * 256 * 256 * 2;
constexpr size_t W_LAM = W_S3 + (size_t)32 * 256 * 384 * 2, W_END = al256(W_LAM + 32 * 64 * 2 * 4);
constexpr size_t O_HB = W_END, O_HB2 = O_HB + (size_t)T * D * 2, O_SSQ = O_HB2 + (size_t)T * D * 2, O_PB = O_SSQ + (size_t)9 * T * 4, O_BIG = O_PB + (size_t)T * PLE * 2;
constexpr size_t O_ACT = O_BIG;
constexpr size_t O_PP = O_BIG;
constexpr size_t O_PROJ = O_BIG, O_SMALL = O_PROJ + (size_t)TH * PROJ_LD * 2, O_XS = O_SMALL + (size_t)TH * 32 * 4;
constexpr size_t O_S5S = O_XS + (size_t)CHH * 32 * 384 * 2, O_GST = O_S5S + (size_t)CHH * 32 * 128 * 4,
    OUT_GATES = 0, OUT_GS5 = (size_t)TH * 3072 * 2, OUT_YS5 = OUT_GS5 + (size_t)TH * 512 * 2;
constexpr size_t O_GDEC = O_GST + (size_t)SEQH * 4 * NC64 * 8192 * 4;
constexpr size_t O_SST = al256(O_GDEC + (size_t)SEQH * 4 * NC64 * 64 * 4), O_SDEC = O_SST + (size_t)SEQH * 8 * NC128 * 8192 * 4;
constexpr size_t O_BCG = al256(O_SDEC + (size_t)SEQH * 8 * NC128 * 4), O_SG = O_BCG + (size_t)SEQH * 4 * NC64 * 4096 * 4, O_MG = O_SG + (size_t)TH * D * 2, O_MIXEND = O_MG + (size_t)TH * D * 2;
constexpr size_t O_FFNEND = O_ACT + (size_t)T * DFFP * 2, O_PLEEND = O_PP + (size_t)T * D * 2;
constexpr size_t WS_NEED0 = (O_MIXEND > O_FFNEND ? (O_MIXEND > O_PLEEND ? O_MIXEND : O_PLEEND) : (O_FFNEND > O_PLEEND ? O_FFNEND : O_PLEEND));
constexpr size_t O_BAR = al256(WS_NEED0), WS_NEED = O_BAR + 16384;
constexpr int LDS_BYTES = 144 * 1024, LDS_TOTAL = LDS_BYTES + 16;

struct Params {
    const float* in[38];
    float* out;
    unsigned char* ws;
};
struct Ctx { int bid, nblk, tid, nthr; unsigned char* smem; };
#ifndef CPU_EMU
#define PRM const __attribute__((address_space(4))) Params&
#else
#define PRM const Params&
#endif

union FU { float f; unsigned u; };
DEV float bf2f(bf16_t b) { FU x; x.u = ((unsigned)b) << 16; return x.f; }
DEV bf16_t f2bf(float f) { FU x; x.f = f; unsigned u = x.u; u += 0x7FFFu + ((u >> 16) & 1u); return (bf16_t)(u >> 16); }
DEV unsigned pack2(float lo, float hi) { return (unsigned)f2bf(lo) | ((unsigned)f2bf(hi) << 16); }
#ifndef CPU_EMU
#define FEXP(x) __expf(x)
#define FLOG(x) __logf(x)
#define FRCP(x) __frcp_rn(x)
#define LDS_ADD(p, v) atomicAdd((p), (v))
#else
#define FEXP(x) expf(x)
#define FLOG(x) logf(x)
#define FRCP(x) (1.0f / (x))
#define LDS_ADD(p, v) (*(p) += (v))
#endif
typedef unsigned long long u64;
DEV u64 fx24(float v) { return (u64)(v * 16777216.0f + 0.5f); }
DEV float unfx24(u64 v) { return (float)v * (1.0f / 16777216.0f); }
DEV float sigm(float x) { return FRCP(1.f + FEXP(-x)); }
DEV float silu(float x) { return x * FRCP(1.f + FEXP(-x)); }
DEV float softplus(float x) { return x > 20.f ? x : FLOG(1.f + FEXP(x)); }
DEV float logsig(float x) { return fminf(x, 0.f) - FLOG(1.f + FEXP(-fabsf(x))); }
DEV float gelu_t(float x) { const float u = 0.7978845608f * (x + 0.044715f * x * x * x); return x * FRCP(1.f + FEXP(-2.f * u)); }
struct alignas(16) U4 { unsigned x, y, z, w; };
struct alignas(16) F4 { float x, y, z, w; };
DEV void st_bf8(bf16_t* p, const float* v) { U4 w; w.x = pack2(v[0], v[1]); w.y = pack2(v[2], v[3]); w.z = pack2(v[4], v[5]); w.w = pack2(v[6], v[7]); *(U4*)p = w; }
DEV void ld_bf8(const bf16_t* p, float* v) { U4 w = *(const U4*)p; v[0] = bf2f((bf16_t)(w.x & 0xffff)); v[1] = bf2f((bf16_t)(w.x >> 16)); v[2] = bf2f((bf16_t)(w.y & 0xffff)); v[3] = bf2f((bf16_t)(w.y >> 16));
    v[4] = bf2f((bf16_t)(w.z & 0xffff)); v[5] = bf2f((bf16_t)(w.z >> 16)); v[6] = bf2f((bf16_t)(w.w & 0xffff)); v[7] = bf2f((bf16_t)(w.w >> 16)); }
DEV void up_bf8(U4 w, float* v) { v[0] = bf2f((bf16_t)(w.x & 0xffff)); v[1] = bf2f((bf16_t)(w.x >> 16)); v[2] = bf2f((bf16_t)(w.y & 0xffff)); v[3] = bf2f((bf16_t)(w.y >> 16));
    v[4] = bf2f((bf16_t)(w.z & 0xffff)); v[5] = bf2f((bf16_t)(w.z >> 16)); v[6] = bf2f((bf16_t)(w.w & 0xffff)); v[7] = bf2f((bf16_t)(w.w >> 16)); }
DEV void st_f8(float* p, const float* v) { F4 a, b; a.x = v[0]; a.y = v[1]; a.z = v[2]; a.w = v[3]; b.x = v[4]; b.y = v[5]; b.z = v[6]; b.w = v[7]; *(F4*)p = a; *(F4*)(p + 4) = b; }
DEV void ld_f8(const float* p, float* v) { F4 a = *(const F4*)p, b = *(const F4*)(p + 4); v[0] = a.x; v[1] = a.y; v[2] = a.z; v[3] = a.w; v[4] = b.x; v[5] = b.y; v[6] = b.z; v[7] = b.w; }

struct Unit { const bf16_t* A; const bf16_t* B; int lda, ldb, nt, pm, pn, sub; };

struct SchedSimple {
    const bf16_t* A; const bf16_t* Bt; int lda, ldb, K, nM, nN, nwg, G, c;
    DEV void init(const bf16_t* A_, int lda_, const bf16_t* Bt_, int ldb_, int M, int N, int K_, int G_, int c_) { A = A_; Bt = Bt_; lda = lda_; ldb = ldb_; K = K_; nM = M / 256; nN = N / 256; nwg = nM * nN; G = G_; c = c_; }
    DEV bool next(int i, Unit& u) const {
        const long L = (long)i * G + c; if (L >= nwg) return false;
        int wgid = (int)L; { const int q = nwg / 8, r = nwg % 8, xcd = wgid % 8, off = wgid / 8; wgid = (xcd < r ? xcd * (q + 1) : r * (q + 1) + (xcd - r) * q) + off; }
        const int nig = 8 * nN, gid = wgid / nig, fm = gid * 8, gsz = (nM - fm) < 8 ? (nM - fm) : 8;
        u.pm = fm + ((wgid % nig) % gsz); u.pn = (wgid % nig) / gsz; u.sub = 0;
        u.A = A + (size_t)u.pm * 256 * lda; u.B = Bt + (size_t)u.pn * 256 * ldb; u.lda = lda; u.ldb = ldb; u.nt = K / 64; return true;
    }
};
struct SchedS5 {
    const bf16_t* XS; const bf16_t* Bt; int K, nM, G, c;
    DEV bool next(int i, Unit& u) const {
        const int L = i * G + c; if (L >= nM * 32) return false;
        u.pm = L / 32; u.sub = L % 32; u.pn = 0;
        u.A = XS + (size_t)u.pm * 256 * (32 * 384) + u.sub * 384; u.lda = 32 * 384; u.B = Bt + (size_t)u.sub * 256 * K; u.ldb = K; u.nt = K / 64; return true;
    }
};
struct SchedMerge {
    const bf16_t* WBR; const bf16_t* YS5; const bf16_t* PROJ; int ntiles, G, c;
    DEV bool next(int i, Unit& u) const {
        const int tl = (i / 3) * G + c; if (tl >= ntiles) return false;
        const int k = i % 3; const int x = tl % 8, idx = tl / 8;
        u.pm = x * (ntiles / 32) + idx / 4; u.pn = idx % 4; u.sub = k;
        if (k == 0) { u.A = YS5 + (size_t)u.pm * 256 * 512; u.lda = 512; } else { u.A = PROJ + (size_t)u.pm * 256 * PROJ_LD + (k == 1 ? PC_GO : PC_Z); u.lda = PROJ_LD; }
        u.B = WBR + ((size_t)k * 1024 + u.pn * 256) * 512; u.ldb = 512; u.nt = 8;
        return true;
    }
};

DEV unsigned ssq_fix(float ss) { return (unsigned)(ss * 16384.0f + 0.5f); }
DEV float rstd_of(float raw) { FU x; x.f = raw; return 1.0f / sqrtf((float)x.u * (1.0f / (16384.0f * D)) + EPS); }
DEV float ssq_raw(const unsigned* p) { FU x; x.u = *p; return x.f; }
struct EpiSwiglu { static constexpr bool GU = true, SSQ = false, RV = true, PF = false; bf16_t* act; const unsigned* ssq_in;
    DEV float rowval(const Unit&, int row) const { return ssq_raw(ssq_in + row); }
    DEV void store_gu(const Unit&, int row, int hid, const float* g, const float* u, float rv) const { const float r = rstd_of(rv); float v[8]; for (int i = 0; i < 8; ++i) v[i] = silu(g[i] * r) * (u[i] * r); st_bf8(act + (size_t)row * DFFP + hid, v); } };
struct EpiResid { static constexpr bool GU = false, SSQ = true, RV = false, PF = true; const bf16_t* hb_src; bf16_t* hb_dst; float scale; unsigned* ssq;
    DEV float rowval(const Unit&, int) const { return 0.f; }
    DEV void prefetch(const Unit&, int row, int col, U4& a, U4& b, float& c) const { a = *(const U4*)(hb_src + (size_t)row * D + col); b = a; c = 0.f; }
    DEV float store8p(const Unit&, int row, int col, const float* v, float, const U4& a, const U4&, float) const { float s[8], o[8], ss = 0.f; up_bf8(a, s);
        for (int i = 0; i < 8; ++i) { o[i] = bf2f(f2bf(s[i] + scale * v[i])); ss += o[i] * o[i]; }
        st_bf8(hb_dst + (size_t)row * D + col, o); return ss; }
    DEV float store8(const Unit& u, int row, int col, const float* v, float rv) const { U4 a, b; float c; prefetch(u, row, col, a, b, c); return store8p(u, row, col, v, rv, a, b, c); } };
struct EpiWin { static constexpr bool GU = false, SSQ = false, RV = true, PF = false; bf16_t* XS; bf16_t* PROJ; float* SMALL; bf16_t* GATES; const unsigned* ssq_in;
    DEV float rowval(const Unit&, int row) const { return ssq_raw(ssq_in + row); }
    DEV void store8(const Unit& u, int row, int col, const float* vin, float rv) const { const float r = rstd_of(rv); float v[8]; for (int i = 0; i < 8; ++i) v[i] = vin[i] * r;
        if (u.pn < 2) st_bf8(XS + ((size_t)(row >> 4) * 32 + (col >> 4)) * 384 + (row & 15) * 16 + (col & 15), v);
        else if (u.pn < 14) st_bf8(PROJ + (size_t)row * PROJ_LD + (col - 512), v);
        else if (u.pn == 14) { const int c = col - 3584; if (c < 32) st_f8(SMALL + (size_t)row * 32 + c, v); }
        else { float t[8]; for (int i = 0; i < 8; ++i) t[i] = sigm(v[i]); st_bf8(GATES + (size_t)row * 3072 + (col - 3840), t); } } };
struct EpiS5P1 { static constexpr bool GU = false, SSQ = false, RV = false, PF = false; float* S5S;
    DEV float rowval(const Unit&, int) const { return 0.f; }
    DEV void store8(const Unit& u, int row, int col, const float* v, float) const { if (col < 128) st_f8(S5S + ((size_t)row * 32 + u.sub) * 128 + col, v); } };
struct EpiS5P3 { static constexpr bool GU = false, SSQ = false, RV = false, PF = false; bf16_t* GS5;
    DEV float rowval(const Unit&, int) const { return 0.f; }
    DEV void store8(const Unit& u, int row, int col, const float* v, float) const { float o[8]; for (int i = 0; i < 8; ++i) o[i] = gelu_t(v[i]); st_bf8(GS5 + ((size_t)row * 16 + (col >> 4)) * 512 + u.sub * 16 + (col & 15), o); } };
struct EpiGlu { static constexpr bool GU = false, SSQ = false, RV = false, PF = true; const bf16_t* GS5; bf16_t* YS5;
    DEV float rowval(const Unit&, int) const { return 0.f; }
    DEV void prefetch(const Unit&, int row, int col, U4& a, U4& b, float& c) const { a = *(const U4*)(GS5 + (size_t)row * 512 + col); b = a; c = 0.f; }
    DEV float store8p(const Unit&, int row, int col, const float* v, float, const U4& a, const U4&, float) const { float g[8], o[8]; up_bf8(a, g); for (int i = 0; i < 8; ++i) o[i] = g[i] * sigm(v[i]); st_bf8(YS5 + (size_t)row * 512 + col, o); return 0.f; }
    DEV void store8(const Unit& u, int row, int col, const float* v, float rv) const { U4 a, b; float c; prefetch(u, row, col, a, b, c); (void)store8p(u, row, col, v, rv, a, b, c); } };
struct EpiMerge { static constexpr bool GU = false, SSQ = false, RV = false, PF = true; const bf16_t* GATES; bf16_t* MG;
    DEV float rowval(const Unit&, int) const { return 0.f; }
    DEV void prefetch(const Unit& u, int row, int col, U4& a, U4& b, float& c) const { a = *(const U4*)(GATES + (size_t)row * 3072 + u.sub * 1024 + col);
        if (u.sub == 0) { b.x = b.y = b.z = b.w = 0u; } else b = *(const U4*)(MG + (size_t)row * D + col); c = 0.f; }
    DEV float store8p(const Unit&, int row, int col, const float* v, float, const U4& a, const U4& b, float) const { float g[8], m[8], t[8]; up_bf8(a, g); up_bf8(b, m);
        for (int i = 0; i < 8; ++i) t[i] = m[i] + g[i] * v[i]; st_bf8(MG + (size_t)row * D + col, t); return 0.f; }
    DEV void store8(const Unit& u, int row, int col, const float* v, float rv) const { U4 a, b; float c; prefetch(u, row, col, a, b, c); (void)store8p(u, row, col, v, rv, a, b, c); } };
struct EpiBf { static constexpr bool GU = false, SSQ = false, RV = false, PF = false; bf16_t* O; int ld;
    DEV float rowval(const Unit&, int) const { return 0.f; }
    DEV void store8(const Unit&, int row, int col, const float* v, float) const { st_bf8(O + (size_t)row * ld + col, v); } };
struct EpiPle { static constexpr bool GU = false, SSQ = true, RV = false, PF = true; const bf16_t* hb_src; bf16_t* PPb; bf16_t* hb_dst; const unsigned* ssq_in; unsigned* ssq;
    DEV float rowval(const Unit&, int) const { return 0.f; }
    DEV void prefetch(const Unit& u, int row, int col, U4& a, U4& b, float& c) const { const size_t off = (size_t)row * D + col;
        if (u.sub == 0) { a.x = a.y = a.z = a.w = 0u; b = a; c = 0.f; } else { a = *(const U4*)(hb_src + off); b = *(const U4*)(PPb + off); c = ssq_raw(ssq_in + row); } }
    DEV float store8p(const Unit& u, int row, int col, const float* v, float, const U4& a, const U4& b, float c) const { const size_t off = (size_t)row * D + col;
        if (u.sub == 0) { st_bf8(PPb + off, v); return 0.f; }
        const float r = rstd_of(c); float s[8], p[8], o[8], ss = 0.f; up_bf8(a, s); up_bf8(b, p); for (int i = 0; i < 8; ++i) { o[i] = bf2f(f2bf(s[i] + sigm(v[i] * r) * p[i])); ss += o[i] * o[i]; }
        st_bf8(hb_dst + off, o); return ss; }
    DEV float store8(const Unit& u, int row, int col, const float* v, float rv) const { U4 a, b; float c; prefetch(u, row, col, a, b, c); return store8p(u, row, col, v, rv, a, b, c); } };
struct SchedPle { const bf16_t* PB; const bf16_t* WPP; const bf16_t* HB; const bf16_t* WPG; int ntiles, G, c;
    DEV bool next(int i, Unit& u) const {
        const int tl = (i >> 1) * G + c; if (tl >= ntiles) return false;
        u.sub = i & 1; u.pm = tl >> 2; u.pn = tl & 3;
        if (u.sub == 0) { u.A = PB + (size_t)u.pm * 256 * PLE; u.lda = PLE; u.B = WPP + (size_t)u.pn * 256 * PLE; u.ldb = PLE; u.nt = PLE / 64; }
        else { u.A = HB + (size_t)u.pm * 256 * D; u.lda = D; u.B = WPG + (size_t)u.pn * 256 * D; u.ldb = D; u.nt = D / 64; }
        return true; } };

#ifndef CPU_EMU
#define LAS __attribute__((address_space(3)))
typedef short bf16x8 __attribute__((ext_vector_type(8)));
typedef float f32x4 __attribute__((ext_vector_type(4)));
constexpr int HTB = 128 * 64 * 2;
__device__ __forceinline__ int lds_byte(int r, int c) { const int st = (r >> 4) * 2 + (c >> 5), rr = r & 15, cc = c & 31, ob = rr * 64 + cc * 2; return st * 1024 + (ob ^ (((ob >> 9) & 1) << 5)); }
__device__ __forceinline__ void stage_rc(int b, int& R, int& C) { const int st = b / 1024, sb = b % 1024, swz = sb ^ (((sb >> 9) & 1) << 5); R = (st >> 1) * 16 + swz / 64; C = (st & 1) * 32 + (swz % 64) / 2; }
__device__ __forceinline__ int perm32(int rho) { const int n = rho >> 4, i = rho & 15; return 8 * (i >> 2) + 4 * n + (i & 3); }

template <class E> __device__ __forceinline__ void epi_apply(const E& e, const f32x4 (&acc)[2][2][4][2], const Unit& u, int wr, int wc, int fr, int fq, const float (&rs)[8]) {
    if constexpr (E::GU) {
#pragma unroll
        for (int ai = 0; ai < 2; ++ai)
#pragma unroll
            for (int m = 0; m < 4; ++m) { const int row = u.pm * 256 + ai * 128 + wr * 64 + m * 16 + fr; float g[8], uu[8];
#pragma unroll
                for (int j = 0; j < 4; ++j) { g[j] = acc[ai][0][m][0][j]; g[4 + j] = acc[ai][0][m][1][j]; uu[j] = acc[ai][1][m][0][j]; uu[4 + j] = acc[ai][1][m][1][j]; }
                e.store_gu(u, row, u.pn * 128 + wc * 32 + 8 * fq, g, uu, rs[ai * 4 + m]); }
    } else if constexpr (E::PF) {
#pragma unroll
        for (int ai = 0; ai < 2; ++ai) {
            U4 pa[8], pb[8]; float pc[8];
#pragma unroll
            for (int q = 0; q < 8; ++q) { const int row = u.pm * 256 + ai * 128 + wr * 64 + (q >> 1) * 16 + fr, col = u.pn * 256 + (q & 1) * 128 + wc * 32 + 8 * fq; e.prefetch(u, row, col, pa[q], pb[q], pc[q]); }
#pragma unroll
            for (int m = 0; m < 4; ++m) { const int row = u.pm * 256 + ai * 128 + wr * 64 + m * 16 + fr; float ss = 0.f;
#pragma unroll
                for (int bj = 0; bj < 2; ++bj) { const int col = u.pn * 256 + bj * 128 + wc * 32 + 8 * fq; float v[8];
#pragma unroll
                    for (int j = 0; j < 4; ++j) { v[j] = acc[ai][bj][m][0][j]; v[4 + j] = acc[ai][bj][m][1][j]; }
                    ss += e.store8p(u, row, col, v, rs[ai * 4 + m], pa[m * 2 + bj], pb[m * 2 + bj], pc[m * 2 + bj]); }
                if constexpr (E::SSQ) { ss += __shfl_xor(ss, 16, 64); ss += __shfl_xor(ss, 32, 64); if (fq == 0) atomicAdd(e.ssq + row, ssq_fix(ss)); } } }
    } else {
#pragma unroll
        for (int ai = 0; ai < 2; ++ai)
#pragma unroll
            for (int m = 0; m < 4; ++m)
            { const int row = u.pm * 256 + ai * 128 + wr * 64 + m * 16 + fr; float ss = 0.f;
#pragma unroll
                for (int bj = 0; bj < 2; ++bj) { const int col = u.pn * 256 + bj * 128 + wc * 32 + 8 * fq; float v[8];
#pragma unroll
                    for (int j = 0; j < 4; ++j) { v[j] = acc[ai][bj][m][0][j]; v[4 + j] = acc[ai][bj][m][1][j]; }
                    if constexpr (E::SSQ) ss += e.store8(u, row, col, v, rs[ai * 4 + m]); else e.store8(u, row, col, v, rs[ai * 4 + m]); }
                if constexpr (E::SSQ) { ss += __shfl_xor(ss, 16, 64); ss += __shfl_xor(ss, 32, 64); if (fq == 0) atomicAdd(e.ssq + row, ssq_fix(ss)); } }
    }
}

template <class Epi, class Sched>
__device__ __forceinline__ void gemm_phase(const Ctx& ctx, const Sched& S, const Epi& E) {
    LAS unsigned char* lds = (LAS unsigned char*)ctx.smem;
    const int tid = ctx.tid, wid = __builtin_amdgcn_readfirstlane(tid >> 6), lane = tid & 63, wr = wid >> 2, wc = wid & 3, fr = lane & 15, fq = lane >> 4;
    int RA[2], RB[2], CC[2];
#pragma unroll
    for (int i = 0; i < 2; ++i) { int R, C; stage_rc(tid * 16 + i * 8192, R, C); RA[i] = R; RB[i] = (R & ~31) + perm32(R & 31); CC[i] = C; }
    const size_t kstep = 128;
    const unsigned ldsw = (unsigned)wid * 1024u;
    const int aoff = lds_byte(wr * 64 + fr, fq * 8), boff = lds_byte(wc * 32 + fr, fq * 8);
#define G_SA(b, h) (((b) * 2 + (h)) * HTB)
#define G_SB(b, h) ((4 + (b) * 2 + (h)) * HTB)
#define G_STAGE(bufoff, gbase, RR, ld) do { _Pragma("unroll") for (int _i = 0; _i < 2; ++_i) \
        __builtin_amdgcn_global_load_lds((const unsigned*)((const char*)(gbase) + (size_t)((unsigned)(RR[_i] * (ld) + CC[_i]) * 2u)), (LAS unsigned*)(lds + (bufoff) + ldsw + _i * 8192), 16, 0, 0); } while (0)
#define G_LDA(dst, b, h) do { _Pragma("unroll") for (int m = 0; m < 4; ++m) _Pragma("unroll") for (int k = 0; k < 2; ++k) dst[m][k] = *(const LAS bf16x8*)(lds + G_SA(b, h) + aoff + m * 2048 + k * 1024); } while (0)
#define G_LDB(dst, b, h) do { _Pragma("unroll") for (int n = 0; n < 2; ++n) _Pragma("unroll") for (int k = 0; k < 2; ++k) dst[n][k] = *(const LAS bf16x8*)(lds + G_SB(b, h) + boff + n * 2048 + k * 1024); } while (0)
#define G_MMA(ai, bj, At, Bt) do { __builtin_amdgcn_s_setprio(1); _Pragma("unroll") for (int m = 0; m < 4; ++m) _Pragma("unroll") for (int n = 0; n < 2; ++n) _Pragma("unroll") for (int k = 0; k < 2; ++k) \
        acc[ai][bj][m][n] = __builtin_amdgcn_mfma_f32_16x16x32_bf16(Bt[n][k], At[m][k], acc[ai][bj][m][n], 0, 0, 0); __builtin_amdgcn_s_setprio(0); } while (0)
#define G_WAIT_V(n) asm volatile("s_waitcnt vmcnt(" #n ")" ::: "memory")
#define G_WAIT_L(n) asm volatile("s_waitcnt lgkmcnt(" #n ")" ::: "memory")
#define G_BAR __builtin_amdgcn_s_barrier()
#define G_SCHED __builtin_amdgcn_sched_barrier(0)
    Unit cur, nxt; int ui = 0;
    if (!S.next(0, cur)) return;
    f32x4 acc[2][2][4][2];
#pragma unroll
    for (int a = 0; a < 2; ++a)
#pragma unroll
        for (int b = 0; b < 2; ++b)
#pragma unroll
            for (int m = 0; m < 4; ++m)
#pragma unroll
                for (int n = 0; n < 2; ++n) acc[a][b][m][n] = (f32x4){0.f, 0.f, 0.f, 0.f};
    bf16x8 At[4][2], B0[2][2], B1[2][2];
    float rs[8] = {0.f, 0.f, 0.f, 0.f, 0.f, 0.f, 0.f, 0.f};
    const char* cA = (const char*)cur.A; const char* cB = (const char*)cur.B; int lda = cur.lda, ldb = cur.ldb, nt = cur.nt;
    {
        const size_t hA = (size_t)128 * lda * 2, hB = (size_t)128 * ldb * 2;
        G_STAGE(G_SB(0, 0), cB, RB, ldb); G_STAGE(G_SA(0, 0), cA, RA, lda); G_STAGE(G_SB(0, 1), cB + hB, RB, ldb); G_STAGE(G_SA(0, 1), cA + hA, RA, lda);
        if (wr == 1) G_BAR;
        G_WAIT_V(4); G_BAR;
        G_STAGE(G_SB(1, 0), cB + kstep, RB, ldb); G_STAGE(G_SA(1, 0), cA + kstep, RA, lda); G_STAGE(G_SB(1, 1), cB + hB + kstep, RB, ldb);
        G_WAIT_V(6); G_BAR;
    }
    for (;;) {
        const bool has_next = S.next(ui + 1, nxt);
        const char* nA = has_next ? (const char*)nxt.A : cA; const char* nB = has_next ? (const char*)nxt.B : cB;
        const int nlda = has_next ? nxt.lda : lda, nldb = has_next ? nxt.ldb : ldb;
        const size_t hA = (size_t)128 * lda * 2;
        for (int t = 0; t < nt; t += 2) {
            const bool last = (t == nt - 2);
            if constexpr (Epi::RV) { if (last) {
#pragma unroll
                for (int q = 0; q < 8; ++q) rs[q] = E.rowval(cur, cur.pm * 256 + (q >> 2) * 128 + wr * 64 + (q & 3) * 16 + fr); } }
            const char* a1 = cA + (size_t)(t + 1) * kstep;
            const char* a2 = last ? nA : cA + (size_t)(t + 2) * kstep; const char* b2 = last ? nB : cB + (size_t)(t + 2) * kstep;
            const int lda2 = last ? nlda : lda, ldb2 = last ? nldb : ldb;
            const size_t hA2 = (size_t)128 * lda2 * 2, hB2 = (size_t)128 * ldb2 * 2;
            const char* a3 = a2 + kstep; const char* b3 = b2 + kstep;
            G_LDB(B0, 0, 0); G_SCHED; G_LDA(At, 0, 0); G_STAGE(G_SA(1, 1), a1 + hA, RA, lda);
            G_WAIT_L(8); G_BAR; G_WAIT_L(0); G_MMA(0, 0, At, B0); G_BAR; G_SCHED;
            G_LDB(B1, 0, 1); G_STAGE(G_SB(0, 0), b2, RB, ldb2);
            G_BAR; G_WAIT_L(0); G_MMA(0, 1, At, B1); G_BAR;
            G_LDA(At, 0, 1); G_STAGE(G_SA(0, 0), a2, RA, lda2);
            G_BAR; G_WAIT_L(0); G_MMA(1, 0, At, B0); G_BAR; G_SCHED;
            G_STAGE(G_SB(0, 1), b2 + hB2, RB, ldb2);
            G_WAIT_V(6); G_BAR; G_MMA(1, 1, At, B1); G_BAR;
            G_LDB(B0, 1, 0); G_SCHED; G_LDA(At, 1, 0); G_STAGE(G_SA(0, 1), a2 + hA2, RA, lda2);
            G_WAIT_L(8); G_BAR; G_WAIT_L(0); G_MMA(0, 0, At, B0); G_BAR; G_SCHED;
            G_LDB(B1, 1, 1); G_STAGE(G_SB(1, 0), b3, RB, ldb2);
            G_BAR; G_WAIT_L(0); G_MMA(0, 1, At, B1); G_BAR;
            G_LDA(At, 1, 1); G_STAGE(G_SA(1, 0), a3, RA, lda2);
            G_BAR; G_WAIT_L(0); G_MMA(1, 0, At, B0); G_BAR; G_SCHED;
            G_STAGE(G_SB(1, 1), b3 + hB2, RB, ldb2);
            G_WAIT_V(6); G_BAR; G_MMA(1, 1, At, B1); G_BAR;
        }
        epi_apply(E, acc, cur, wr, wc, fr, fq, rs);
        if (!has_next) break;
#pragma unroll
        for (int a = 0; a < 2; ++a)
#pragma unroll
            for (int b = 0; b < 2; ++b)
#pragma unroll
                for (int m = 0; m < 4; ++m)
#pragma unroll
                    for (int n = 0; n < 2; ++n) acc[a][b][m][n] = (f32x4){0.f, 0.f, 0.f, 0.f};
        cur = nxt; cA = nA; cB = nB; lda = nlda; ldb = nldb; nt = cur.nt; ++ui;
    }
    G_WAIT_V(0);
    if (wr == 0) G_BAR;
    G_BAR;
}
#else
template <class Epi, class Sched>
inline void gemm_phase(const Ctx& ctx, const Sched& S, const Epi& E) {
    Unit u;
    for (int i = 0; S.next(i, u); ++i) {
        const int K = u.nt * 64;
        for (int r = 0; r < 256; ++r) {
            float arow[4096]; for (int k = 0; k < K; ++k) arow[k] = bf2f(u.A[(size_t)r * u.lda + k]);
            if constexpr (Epi::GU) {
                for (int c0 = 0; c0 < 128; c0 += 8) { float g[8], uu[8];
                    for (int j = 0; j < 8; ++j) { float sg = 0, su = 0; const bf16_t* bg = u.B + (size_t)(c0 + j) * u.ldb; const bf16_t* bu = u.B + (size_t)(128 + c0 + j) * u.ldb;
                        for (int k = 0; k < K; ++k) { sg += arow[k] * bf2f(bg[k]); su += arow[k] * bf2f(bu[k]); } g[j] = sg; uu[j] = su; }
                    E.store_gu(u, u.pm * 256 + r, u.pn * 128 + c0, g, uu, E.rowval(u, u.pm * 256 + r)); }
            } else {
                for (int c0 = 0; c0 < 256; c0 += 8) { float v[8];
                    for (int j = 0; j < 8; ++j) { float s = 0; const bf16_t* b = u.B + (size_t)(c0 + j) * u.ldb; for (int k = 0; k < K; ++k) s += arow[k] * bf2f(b[k]); v[j] = s; }
                    if constexpr (Epi::SSQ) { const float q = E.store8(u, u.pm * 256 + r, u.pn * 256 + c0, v, E.rowval(u, u.pm * 256 + r));
#pragma omp atomic
                        E.ssq[u.pm * 256 + r] += ssq_fix(q); } else E.store8(u, u.pm * 256 + r, u.pn * 256 + c0, v, E.rowval(u, u.pm * 256 + r)); }
            }
        }
    }
}
#endif

template <class F> DEV void mm_nt(const bf16_t* As, int lda, const bf16_t* Bs, int ldb, int M, int N, int K, int causal, const Ctx& ctx, F epi) {
    const int ntn = N / 16, ntiles = (M / 16) * ntn;
#ifndef CPU_EMU
    const int wave = ctx.tid >> 6, lane = ctx.tid & 63, nw = ctx.nthr >> 6, r = lane & 15, q = lane >> 4;
    for (int t = wave; t < ntiles; t += nw) {
        const int tm = t / ntn, tn = t % ntn; const int lim = (tm * 16 + 16 + 31) & ~31;
        if (causal == 1 && tn * 16 >= lim) continue;
        const int kend = (causal == 2 && lim < K) ? lim : K;
        f32x4 acc = {0.f, 0.f, 0.f, 0.f};
        const bf16_t* ap = As + (tm * 16 + r) * lda + q * 8; const bf16_t* bp = Bs + (tn * 16 + r) * ldb + q * 8;
        for (int k0 = 0; k0 < kend; k0 += 32) { const bf16x8 a = *(const bf16x8*)(ap + k0); const bf16x8 b = *(const bf16x8*)(bp + k0); acc = __builtin_amdgcn_mfma_f32_16x16x32_bf16(a, b, acc, 0, 0, 0); }
#pragma unroll
        for (int j = 0; j < 4; ++j) epi(tm * 16 + q * 4 + j, tn * 16 + r, acc[j]);
    }
#else
    for (int t = 0; t < ntiles; ++t) {
        const int tm = t / ntn, tn = t % ntn; const int lim = (tm * 16 + 16 + 31) & ~31;
        if (causal == 1 && tn * 16 >= lim) continue;
        const int kend = (causal == 2 && lim < K) ? lim : K;
        for (int i = 0; i < 16; ++i) for (int j = 0; j < 16; ++j) { float s = 0; for (int k = 0; k < kend; ++k) s += bf2f(As[(tm * 16 + i) * lda + k]) * bf2f(Bs[(tn * 16 + j) * ldb + k]); epi(tm * 16 + i, tn * 16 + j, s); }
    }
#endif
}

DEV void conv_job(const Ctx& ctx, const float* src, int sld, int scol0, int ncols, int Ksrc, bf16_t* dst, int dld, int njpad, int Kdst, const float* scale, int mode) {
    float* tile = (float*)ctx.smem;
    const int tilesJ = njpad / 128, tilesK = Kdst / 64, ntl = tilesJ * tilesK;
    const int ncv = ctx.nblk > 64 ? ctx.nblk - 32 : ctx.nblk;
    if (ctx.bid >= ncv) return;
    for (int tl = ctx.bid; tl < ntl; tl += ncv) {
        const int j0 = (tl % tilesJ) * 128, k0 = (tl / tilesJ) * 64;
        for (int e = ctx.tid; e < 2048; e += ctx.nthr) { const int kk = e >> 5, jj = (e & 31) * 4, k = k0 + kk, j = j0 + jj; F4 v; v.x = v.y = v.z = v.w = 0.f;
            if (mode == 3) { if (k < Ksrc) { float t[4]; for (int u = 0; u < 4; ++u) { const int jq = j + u; t[u] = jq < 24 ? src[(size_t)k * sld + (jq < 16 ? 2048 + jq : 3600 + (jq - 16))] : 0.f; } v.x = t[0]; v.y = t[1]; v.z = t[2]; v.w = t[3]; } }
            else if (j < ncols && k < Ksrc) v = *(const F4*)(src + (size_t)k * sld + scol0 + j);
            if (scale && k < Ksrc) { const float sc = scale[k]; v.x *= sc; v.y *= sc; v.z *= sc; v.w *= sc; }
            float* tp = tile + kk * 129 + jj; tp[0] = v.x; tp[1] = v.y; tp[2] = v.z; tp[3] = v.w; }
        SYNC();
        for (int e = ctx.tid; e < 1024; e += ctx.nthr) { const int jj = e >> 3, kv = (e & 7) * 8, j = j0 + jj; int row = j;
            if (mode == 1) row = (j >> 7) * 256 + (j & 127); else if (mode == 2) row = (j >> 7) * 256 + 128 + (j & 127);
            float o[8];
#pragma unroll
            for (int u = 0; u < 8; ++u) o[u] = tile[(kv + u) * 129 + jj];
            st_bf8(dst + (size_t)row * dld + k0 + kv, o); }
        SYNC();
    }
}

DEV void s5_prep_item(const Ctx& ctx, PRM P, int l, int g, bf16_t* BT1, bf16_t* BT3, float* LAM) {
    float* sm = (float*)ctx.smem;
    float* PwR = sm; float* PwI = PwR + 17 * 64; float* BbR = PwI + 17 * 64; float* BbI = BbR + 1024; float* CR = BbI + 1024; float* CI = CR + 1024; float* Kt = CI + 1024;
    const float* lam_re = P.in[8] + ((size_t)l * 32 + g) * 64; const float* lam_im = P.in[9] + ((size_t)l * 32 + g) * 64;
    const float step = expf(P.in[10][l * 32 + g]);
    const float* b_re = P.in[11] + ((size_t)l * 32 + g) * 1024; const float* b_im = P.in[12] + ((size_t)l * 32 + g) * 1024;
    const float* c_re = P.in[13] + ((size_t)l * 32 + g) * 1024; const float* c_im = P.in[14] + ((size_t)l * 32 + g) * 1024;
    const float* dsk = P.in[15] + (size_t)l * 512 + g * 16;
    for (int e = ctx.tid; e < 17 * 64; e += ctx.nthr) { const int tau = e / 64, p = e % 64; const float lr = fminf(lam_re[p], -1e-4f), li = lam_im[p];
        const float mg = expf(lr * step * tau), an = li * step * tau; PwR[e] = mg * cosf(an); PwI[e] = mg * sinf(an); }
    for (int e = ctx.tid; e < 1024; e += ctx.nthr) { const int p = e / 16; const float lr = fminf(lam_re[p], -1e-4f), li = lam_im[p];
        const float mg = expf(lr * step), ar = mg * cosf(li * step), ai = mg * sinf(li * step), den = lr * lr + li * li, nr = ar - 1.f;
        const float fr = (nr * lr + ai * li) / den, fi = (ai * lr - nr * li) / den; const float br = b_re[e], bi = b_im[e];
        BbR[e] = fr * br - fi * bi; BbI[e] = fr * bi + fi * br; CR[e] = c_re[e]; CI[e] = c_im[e]; }
    SYNC();
    for (int e = ctx.tid; e < 4096; e += ctx.nthr) { const int tau = e >> 8, h = (e >> 4) & 15, h2 = e & 15; float s = 0.f;
        for (int p = 0; p < 64; ++p) { const float cr = CR[h * 64 + p], ci = CI[h * 64 + p], pr = PwR[tau * 64 + p], pi = PwI[tau * 64 + p];
            const float er = cr * pr - ci * pi, ei = cr * pi + ci * pr; s += er * BbR[p * 16 + h2] - ei * BbI[p * 16 + h2]; }
        Kt[e] = s; }
    SYNC();
    bf16_t* b3 = BT3 + (size_t)g * 256 * 384;
    for (int e = ctx.tid; e < 256 * 384; e += ctx.nthr) { const int n = e / 384, k = e % 384, t = n >> 4, h = n & 15; float v = 0.f;
        if (k < 256) { const int j = k >> 4, h2 = k & 15; if (j <= t) { v = Kt[((t - j) << 8) + (h << 4) + h2]; if (j == t && h == h2) v += dsk[h]; } }
        else { const int kk = k - 256, p = kk & 63; const float cr = CR[h * 64 + p], ci = CI[h * 64 + p], pr = PwR[(t + 1) * 64 + p], pi = PwI[(t + 1) * 64 + p];
            v = kk < 64 ? (cr * pr - ci * pi) : -(cr * pi + ci * pr); }
        b3[e] = f2bf(v); }
    bf16_t* b1 = BT1 + (size_t)g * 256 * 256;
    for (int e = ctx.tid; e < 256 * 256; e += ctx.nthr) { const int n = e >> 8, k = e & 255, j = k >> 4, h2 = k & 15; float v = 0.f;
        if (n < 128) { const int p = n & 63; const float pr = PwR[(15 - j) * 64 + p], pi = PwI[(15 - j) * 64 + p], br = BbR[p * 16 + h2], bi = BbI[p * 16 + h2];
            v = n < 64 ? (pr * br - pi * bi) : (pr * bi + pi * br); }
        b1[e] = f2bf(v); }
    for (int p = ctx.tid; p < 64; p += ctx.nthr) { LAM[(g * 64 + p) * 2] = PwR[16 * 64 + p]; LAM[(g * 64 + p) * 2 + 1] = PwI[16 * 64 + p]; }
    SYNC();
}

DEV void phase_pconv(const Ctx& ctx, const float* p, bf16_t* dst);
DEV void phase_conv(const Ctx& ctx, PRM P, int l) {
    unsigned char* ws = P.ws;
    const size_t gu = (size_t)D * DFF;
    conv_job(ctx, P.in[3] + l * gu, DFF, 0, DFF, D, (bf16_t*)(ws + W_GU1), D, DFFP, D, P.in[2] + l * D, 1);
    conv_job(ctx, P.in[4] + l * gu, DFF, 0, DFF, D, (bf16_t*)(ws + W_GU1), D, DFFP, D, P.in[2] + l * D, 2);
    conv_job(ctx, P.in[5] + l * gu, D, 0, D, DFF, (bf16_t*)(ws + W_D1), DFFP, D, DFFP, nullptr, 0);
    conv_job(ctx, P.in[31] + l * gu, DFF, 0, DFF, D, (bf16_t*)(ws + W_GU2), D, DFFP, D, P.in[30] + l * D, 1);
    conv_job(ctx, P.in[32] + l * gu, DFF, 0, DFF, D, (bf16_t*)(ws + W_GU2), D, DFFP, D, P.in[30] + l * D, 2);
    conv_job(ctx, P.in[33] + l * gu, D, 0, D, DFF, (bf16_t*)(ws + W_D2), DFFP, D, DFFP, nullptr, 0);
    const float* win = P.in[7] + (size_t)l * D * IN_TOTAL; const float* mn = P.in[6] + l * D; bf16_t* bin = (bf16_t*)(ws + W_IN);
    conv_job(ctx, win, IN_TOTAL, 0, 2048, D, bin, D, 2048, D, mn, 0);
    conv_job(ctx, win, IN_TOTAL, 2064, 1536, D, bin + (size_t)2048 * D, D, 1536, D, mn, 0);
    conv_job(ctx, win, IN_TOTAL, 0, 0, D, bin + (size_t)3584 * D, D, 256, D, mn, 3);
    conv_job(ctx, win, IN_TOTAL, 3608, 3072, D, (bf16_t*)(ws + W_G), D, 3072, D, mn, 0);
    conv_job(ctx, P.in[16] + (size_t)l * 512 * 512, 512, 0, 512, 512, (bf16_t*)(ws + W_GLU), 512, 512, 512, nullptr, 0);
    for (int k = 0; k < 3; ++k) conv_job(ctx, P.in[26 + k] + (size_t)l * 512 * D, D, 0, D, 512, (bf16_t*)(ws + W_BR) + (size_t)k * 1024 * 512, 512, D, 512, nullptr, 0);
    conv_job(ctx, P.in[29] + (size_t)l * D * D, D, 0, D, D, (bf16_t*)(ws + W_OUT), D, D, D, nullptr, 0);
    conv_job(ctx, P.in[35] + (size_t)l * D * D, D, 0, D, D, (bf16_t*)(ws + W_PG), D, D, D, P.in[34] + l * D, 0);
    conv_job(ctx, P.in[36] + (size_t)l * PLE * D, D, 0, D, PLE, (bf16_t*)(ws + W_PP), PLE, D, PLE, nullptr, 0);
    if (l == 0) { float* q = (float*)(ws + O_SSQ) + T; for (size_t i = (size_t)ctx.bid * ctx.nthr + ctx.tid; i < (size_t)8 * T; i += (size_t)ctx.nblk * ctx.nthr) q[i] = 0.f; }
    phase_pconv(ctx, P.in[1] + (size_t)l * T * PLE, (bf16_t*)(ws + O_PB));
    for (int g = ctx.nblk - 1 - ctx.bid; g < 32; g += ctx.nblk) s5_prep_item(ctx, P, l, g, (bf16_t*)(ws + W_S1), (bf16_t*)(ws + W_S3), (float*)(ws + W_LAM));
}

#ifndef CPU_EMU
__device__ __forceinline__ float wave_sum(float v) {
#pragma unroll
    for (int o = 32; o > 0; o >>= 1) v += __shfl_xor(v, o, 64);
    return v;
}
#endif
DEV void phase_norm(const Ctx& ctx, const float* src, bf16_t* dst, unsigned* ssq, int rows) {
#ifndef CPU_EMU
    const int lane = ctx.tid & 63, gw = ctx.bid * (ctx.nthr >> 6) + (ctx.tid >> 6), nw = ctx.nblk * (ctx.nthr >> 6);
    for (int row = gw; row < rows; row += nw) { const F4* s4 = (const F4*)(src + (size_t)row * D); F4 v[4]; float ss = 0.f;
#pragma unroll
        for (int i = 0; i < 4; ++i) { v[i] = s4[i * 64 + lane]; ss += v[i].x * v[i].x + v[i].y * v[i].y + v[i].z * v[i].z + v[i].w * v[i].w; }
        ss = wave_sum(ss); if (lane == 0) ssq[row] = ssq_fix(ss);
#pragma unroll
        for (int i = 0; i < 4; ++i) { unsigned* d = (unsigned*)(dst + (size_t)row * D + (i * 64 + lane) * 4); d[0] = pack2(v[i].x, v[i].y); d[1] = pack2(v[i].z, v[i].w); } }
#else
    for (int row = ctx.bid; row < rows; row += ctx.nblk) { float ss = 0; for (int i = 0; i < D; ++i) { const float x = src[(size_t)row * D + i]; ss += x * x; dst[(size_t)row * D + i] = f2bf(x); } ssq[row] = ssq_fix(ss); }
#endif
}
DEV void phase_final(const Ctx& ctx, const bf16_t* hb, float* out, const float* w, const unsigned* ssq, int rows) {
    const size_t n8 = (size_t)rows * (D / 8);
    for (size_t i = (size_t)ctx.bid * ctx.nthr + ctx.tid; i < n8; i += (size_t)ctx.nblk * ctx.nthr) { const int row = (int)(i >> 7), c8 = (int)(i & 127) * 8; const float r = rstd_of(ssq_raw(ssq + row));
        float v[8], ww[8], o[8]; ld_bf8(hb + i * 8, v); ld_f8(w + c8, ww); for (int u = 0; u < 8; ++u) o[u] = v[u] * r * ww[u]; st_f8(out + i * 8, o); }
}
DEV void phase_pconv(const Ctx& ctx, const float* p, bf16_t* dst) {
    const size_t n8 = (size_t)T * PLE / 8;
    for (size_t i = (size_t)ctx.bid * ctx.nthr + ctx.tid; i < n8; i += (size_t)ctx.nblk * ctx.nthr) { float v[8]; ld_f8(p + i * 8, v); st_bf8(dst + i * 8, v); }
}
DEV void phase_s5scan(const Ctx& ctx, bf16_t* XS, const float* S5S, const float* LAM) {
    for (int t2 = ctx.tid; t2 < 64; t2 += ctx.nthr)
        for (int idx = ctx.bid * 64 + t2; idx < SEQH * 32 * 64; idx += ctx.nblk * 64) {
            const int p = idx & 63, g = (idx >> 6) & 31, b = idx >> 11; const float ar = LAM[(g * 64 + p) * 2], ai = LAM[(g * 64 + p) * 2 + 1]; float hr = 0.f, hi = 0.f;
            float ar_[16], ai_[16], br_[16], bi_[16];
#define S5_LOAD(R, I, c0) { _Pragma("unroll") for (int u = 0; u < 16; ++u) { const size_t base = (size_t)(b * NCH16 + (c0) + u) * 32 + g; R[u] = S5S[base * 128 + p]; I[u] = S5S[base * 128 + 64 + p]; } }
#define S5_STEP(R, I, c0) { _Pragma("unroll") for (int u = 0; u < 16; ++u) { const size_t base = (size_t)(b * NCH16 + (c0) + u) * 32 + g; XS[base * 384 + 256 + p] = f2bf(hr); XS[base * 384 + 320 + p] = f2bf(hi); \
                const float nr = ar * hr - ai * hi + R[u], ni = ar * hi + ai * hr + I[u]; hr = nr; hi = ni; } }
            S5_LOAD(ar_, ai_, 0);
            for (int c0 = 0; c0 < NCH16; c0 += 32) { S5_LOAD(br_, bi_, c0 + 16); S5_STEP(ar_, ai_, c0); if (c0 + 32 < NCH16) S5_LOAD(ar_, ai_, c0 + 32); S5_STEP(br_, bi_, c0 + 16); }
#undef S5_LOAD
#undef S5_STEP
        }
}

DEV void gla_gates(const Ctx& ctx, PRM P, int l, const float* SMALL, int row0, int h, float*& bc, float*& la, float* glr, float* w2s, float* b2s) {
    const float* w2 = P.in[17] + (size_t)l * 16 * 256; const float* b2 = P.in[18] + (size_t)l * 256;
    for (int e = ctx.tid; e < 1024; e += ctx.nthr) { glr[e] = SMALL[(size_t)(row0 + (e >> 4)) * 32 + (e & 15)]; w2s[e] = w2[(e >> 6) * 256 + h * 64 + (e & 63)]; }
    for (int e = ctx.tid; e < 64; e += ctx.nthr) b2s[e] = b2[h * 64 + e];
    SYNC();
    for (int e = ctx.tid; e < 4096; e += ctx.nthr) { const int i = e >> 6, k = e & 63; float x = b2s[k];
#pragma unroll
        for (int r = 0; r < 16; ++r) x += glr[i * 16 + r] * w2s[r * 64 + k];
        la[e] = logsig(x) * (1.0f / 16.0f); }
    SYNC();
    for (int e = ctx.tid; e < 512; e += ctx.nthr) { const int blk = e >> 6, k = e & 63; float run = 0.f;
#pragma unroll
        for (int u = 0; u < 8; ++u) { run += la[(blk * 8 + u) * 64 + k]; bc[(blk * 8 + u) * 64 + k] = run; } }
    SYNC();
    for (int e = ctx.tid; e < 4096; e += ctx.nthr) { const int i = e >> 6, k = e & 63, blk = i >> 3; float off = 0.f; for (int b2i = 0; b2i < blk; ++b2i) off += bc[(b2i * 8 + 7) * 64 + k]; la[e] = bc[e] + off; }
    SYNC();
    { float* t = bc; bc = la; la = t; }
}
DEV void gla_a_item(const Ctx& ctx, PRM P, int l, int it, const bf16_t* PROJ, const float* SMALL, float* GST, float* GDEC, float* BCG) {
    const int b = it / (NC64 * 4), c = (it >> 2) % NC64, h = it & 3, row0 = b * SEQ + c * 64;
    float* bc = (float*)ctx.smem; float* la = bc + 4096; float* glr = la + 4096; float* w2s = glr + 1024; float* b2s = w2s + 1024;
    bf16_t* vT = (bf16_t*)(b2s + 64); bf16_t* kdT = vT + 128 * 72;
#ifndef CPU_EMU
    const int ek = ctx.tid, jk = ek >> 3, kk0 = (ek & 7) * 8; const U4 kraw = *(const U4*)(PROJ + (size_t)(row0 + jk) * PROJ_LD + PC_K + h * 64 + kk0);
    U4 vraw[2];
#pragma unroll
    for (int q = 0; q < 2; ++q) { const int e = ctx.tid + q * 512; vraw[q] = *(const U4*)(PROJ + (size_t)(row0 + (e >> 4)) * PROJ_LD + PC_V + h * 128 + (e & 15) * 8); }
#endif
    gla_gates(ctx, P, l, SMALL, row0, h, bc, la, glr, w2s, b2s);
    { float* bg = BCG + (size_t)it * 4096; for (int e = ctx.tid; e < 512; e += ctx.nthr) { float t[8]; for (int u = 0; u < 8; ++u) t[u] = bc[e * 8 + u]; st_f8(bg + e * 8, t); } }
#ifndef CPU_EMU
    { float kv[8]; up_bf8(kraw, kv);
#pragma unroll
        for (int u = 0; u < 8; ++u) kdT[(kk0 + u) * 72 + jk] = f2bf(kv[u] * FEXP(bc[63 * 64 + kk0 + u] - bc[jk * 64 + kk0 + u])); }
#else
    for (int e = ctx.tid; e < 512; e += ctx.nthr) { const int j = e >> 3, k0 = (e & 7) * 8; float kv[8]; ld_bf8(PROJ + (size_t)(row0 + j) * PROJ_LD + PC_K + h * 64 + k0, kv);
        for (int u = 0; u < 8; ++u) kdT[(k0 + u) * 72 + j] = f2bf(kv[u] * FEXP(bc[63 * 64 + k0 + u] - bc[j * 64 + k0 + u])); }
#endif
#ifndef CPU_EMU
#pragma unroll
    for (int q = 0; q < 2; ++q) { const int e = ctx.tid + q * 512, j = e >> 4, d0 = (e & 15) * 8; const U4 w = vraw[q];
#else
    for (int e = ctx.tid; e < 1024; e += ctx.nthr) { const int j = e >> 4, d0 = (e & 15) * 8; const U4 w = *(const U4*)(PROJ + (size_t)(row0 + j) * PROJ_LD + PC_V + h * 128 + d0);
#endif
        vT[(d0 + 0) * 72 + j] = (bf16_t)(w.x & 0xffff); vT[(d0 + 1) * 72 + j] = (bf16_t)(w.x >> 16); vT[(d0 + 2) * 72 + j] = (bf16_t)(w.y & 0xffff); vT[(d0 + 3) * 72 + j] = (bf16_t)(w.y >> 16);
        vT[(d0 + 4) * 72 + j] = (bf16_t)(w.z & 0xffff); vT[(d0 + 5) * 72 + j] = (bf16_t)(w.z >> 16); vT[(d0 + 6) * 72 + j] = (bf16_t)(w.w & 0xffff); vT[(d0 + 7) * 72 + j] = (bf16_t)(w.w >> 16); }
    SYNC();
    float* st = GST + ((size_t)(b * 4 + h) * NC64 + c) * 8192;
    mm_nt(vT, 72, kdT, 72, 128, 64, 64, 0, ctx, [&](int i, int j, float v) { st[i * 64 + j] = v; });
    for (int k = ctx.tid; k < 64; k += ctx.nthr) GDEC[((size_t)(b * 4 + h) * NC64 + c) * 64 + k] = FEXP(bc[63 * 64 + k]);
    SYNC();
}
DEV void phase_gla_scan(const Ctx& ctx, float* GST, const float* GDEC) {
    const int total = SEQH * 4 * 8192;
    for (int idx = ctx.bid * ctx.nthr + ctx.tid; idx < total; idx += ctx.nblk * ctx.nthr) {
        const int bh = idx >> 13, e = idx & 8191; float* base = GST + (size_t)bh * NC64 * 8192 + e; const float* dec = GDEC + (size_t)bh * NC64 * 64 + (e & 63); float run = 0.f;
        float la_[8], da_[8], lb_[8], db_[8];
#define GS_LOAD(L, Dv, c0) { _Pragma("unroll") for (int u = 0; u < 8; ++u) { L[u] = base[(size_t)((c0) + u) * 8192]; Dv[u] = dec[((c0) + u) * 64]; } }
#define GS_STEP(L, Dv, c0) { _Pragma("unroll") for (int u = 0; u < 8; ++u) { base[(size_t)((c0) + u) * 8192] = run; run = Dv[u] * run + L[u]; } }
        GS_LOAD(la_, da_, 0);
        for (int c0 = 0; c0 < NC64; c0 += 16) { GS_LOAD(lb_, db_, c0 + 8); GS_STEP(la_, da_, c0); if (c0 + 16 < NC64) GS_LOAD(la_, da_, c0 + 16); GS_STEP(lb_, db_, c0 + 8); }
#undef GS_LOAD
#undef GS_STEP
    }
}
DEV void gla_c_item(const Ctx& ctx, PRM P, int l, int it, bf16_t* PROJ, const float* BCG, const float* GST) {
    const int b = it / (NC64 * 4), c = (it >> 2) % NC64, h = it & 3, row0 = b * SEQ + c * 64;
    float* bc = (float*)ctx.smem; float* la = bc + 4096; float* glr = la + 4096; float* w2s = glr + 1024; float* b2s = w2s + 1024; u64* ssq = (u64*)(b2s + 64);
    bf16_t* As = (bf16_t*)(ssq + 64); bf16_t* ks = As + 64 * 136; bf16_t* Bs = ks + 64 * 72; float* o = la;
    o = (float*)(Bs + 128 * 136);
    const float* st = GST + ((size_t)(b * 4 + h) * NC64 + c) * 8192;
#ifndef CPU_EMU
    U4 graw[2];
    { const int e0 = ctx.tid, i = e0 >> 3, k0 = (e0 & 7) * 8; const size_t r = (size_t)(row0 + i) * PROJ_LD; float bcv[8], qv[8], kv[8], qo[8], ko[8], s0[8], s1[8];
        ld_f8(BCG + (size_t)it * 4096 + e0 * 8, bcv); const U4 qraw = *(const U4*)(PROJ + r + PC_Q + h * 64 + k0); const U4 kraw = *(const U4*)(PROJ + r + PC_K + h * 64 + k0);
        ld_f8(st + e0 * 8, s0); ld_f8(st + (e0 + 512) * 8, s1);
        U4 vraw[2];
#pragma unroll
        for (int q = 0; q < 2; ++q) { const int e = e0 + q * 512; vraw[q] = *(const U4*)(PROJ + (size_t)(row0 + (e >> 4)) * PROJ_LD + PC_V + h * 128 + (e & 15) * 8);
            graw[q] = *(const U4*)(PROJ + (size_t)(row0 + (e >> 4)) * PROJ_LD + PC_GO + h * 128 + (e & 15) * 8); }
        up_bf8(qraw, qv); up_bf8(kraw, kv);
#pragma unroll
        for (int u = 0; u < 8; ++u) { qo[u] = qv[u] * 0.125f * FEXP(bcv[u]); ko[u] = kv[u] * FEXP(-bcv[u]); }
        st_bf8(As + i * 136 + k0, qo); st_bf8(ks + i * 72 + k0, ko);
        st_bf8(Bs + (e0 >> 3) * 136 + (e0 & 7) * 8, s0); st_bf8(Bs + ((e0 + 512) >> 3) * 136 + (e0 & 7) * 8, s1);
#pragma unroll
        for (int q = 0; q < 2; ++q) { const int e = e0 + q * 512, j = e >> 4, d0 = (e & 15) * 8; const U4 w = vraw[q]; bf16_t* bp = Bs + d0 * 136 + 64 + j;
            bp[0] = (bf16_t)(w.x & 0xffff); bp[136] = (bf16_t)(w.x >> 16); bp[2 * 136] = (bf16_t)(w.y & 0xffff); bp[3 * 136] = (bf16_t)(w.y >> 16);
            bp[4 * 136] = (bf16_t)(w.z & 0xffff); bp[5 * 136] = (bf16_t)(w.z >> 16); bp[6 * 136] = (bf16_t)(w.w & 0xffff); bp[7 * 136] = (bf16_t)(w.w >> 16); } }
#else
    { const float* bg = BCG + (size_t)it * 4096; for (int e = ctx.tid; e < 512; e += ctx.nthr) { float t[8]; ld_f8(bg + e * 8, t); for (int u = 0; u < 8; ++u) bc[e * 8 + u] = t[u]; } }
    for (int e = ctx.tid; e < 512; e += ctx.nthr) { const int i = e >> 3, k0 = (e & 7) * 8; const size_t r = (size_t)(row0 + i) * PROJ_LD; float qv[8], kv[8], qo[8], ko[8];
        ld_bf8(PROJ + r + PC_Q + h * 64 + k0, qv); ld_bf8(PROJ + r + PC_K + h * 64 + k0, kv);
        for (int u = 0; u < 8; ++u) { const float bb = bc[i * 64 + k0 + u]; qo[u] = qv[u] * 0.125f * FEXP(bb); ko[u] = kv[u] * FEXP(-bb); }
        st_bf8(As + i * 136 + k0, qo); st_bf8(ks + i * 72 + k0, ko); }
    for (int e = ctx.tid; e < 1024; e += ctx.nthr) { const int dv = e >> 3, k0 = (e & 7) * 8; float sv[8]; ld_f8(st + dv * 64 + k0, sv); st_bf8(Bs + dv * 136 + k0, sv); }
    for (int e = ctx.tid; e < 1024; e += ctx.nthr) { const int j = e >> 4, d0 = (e & 15) * 8; const U4 w = *(const U4*)(PROJ + (size_t)(row0 + j) * PROJ_LD + PC_V + h * 128 + d0);
        bf16_t* bp = Bs + d0 * 136 + 64 + j;
        bp[0] = (bf16_t)(w.x & 0xffff); bp[136] = (bf16_t)(w.x >> 16); bp[2 * 136] = (bf16_t)(w.y & 0xffff); bp[3 * 136] = (bf16_t)(w.y >> 16);
        bp[4 * 136] = (bf16_t)(w.z & 0xffff); bp[5 * 136] = (bf16_t)(w.z >> 16); bp[6 * 136] = (bf16_t)(w.w & 0xffff); bp[7 * 136] = (bf16_t)(w.w >> 16); }
#endif
    for (int i = ctx.tid; i < 64; i += ctx.nthr) ssq[i] = 0;
    SYNC();
    mm_nt(As, 136, ks, 72, 64, 64, 64, 0, ctx, [&](int i, int j, float v) { As[i * 136 + 64 + j] = (j <= i) ? f2bf(v) : (bf16_t)0; });
    SYNC();
    mm_nt(As, 136, Bs, 136, 64, 128, 128, 0, ctx, [&](int i, int j, float v) { o[i * 132 + j] = v; LDS_ADD(&ssq[i], fx24(v * v)); });
    SYNC();
    const float* gn = P.in[19] + (size_t)l * 128;
#ifndef CPU_EMU
#pragma unroll
    for (int q = 0; q < 2; ++q) { const int e = ctx.tid + q * 512, i = e >> 4, d0 = (e & 15) * 8; bf16_t* gp = PROJ + (size_t)(row0 + i) * PROJ_LD + PC_GO + h * 128 + d0; float gv[8], ov[8];
        up_bf8(graw[q], gv);
#else
    for (int e = ctx.tid; e < 1024; e += ctx.nthr) { const int i = e >> 4, d0 = (e & 15) * 8; bf16_t* gp = PROJ + (size_t)(row0 + i) * PROJ_LD + PC_GO + h * 128 + d0; float gv[8], ov[8];
        ld_bf8(gp, gv);
#endif
        const float r = 1.0f / sqrtf(unfx24(ssq[i]) * (1.0f / 128) + EPS);
#pragma unroll
        for (int u = 0; u < 8; ++u) ov[u] = o[i * 132 + d0 + u] * r * gn[d0 + u] * silu(gv[u]);
        st_bf8(gp, ov); }
    SYNC();
}

DEV void phase_ssd_conv(const Ctx& ctx, PRM P, int l, const bf16_t* PROJ, bf16_t* XC) {
    const float* cw = P.in[20] + (size_t)l * 4096; const float* cb = P.in[21] + (size_t)l * 1024;
    const int total = (TH / 8) * 128;
    for (int idx = ctx.bid * ctx.nthr + ctx.tid; idx < total; idx += ctx.nblk * ctx.nthr) {
        const int cg = idx & 127, r0 = (idx >> 7) * 8, ch = cg * 8; float w[4][8], bias[8], win[3][8];
#pragma unroll
        for (int k = 0; k < 4; ++k) ld_f8(cw + k * 1024 + ch, w[k]);
        ld_f8(cb + ch, bias);
        const bool first = (r0 % SEQ) == 0;
#pragma unroll
        for (int k = 0; k < 3; ++k) { if (first) { for (int u = 0; u < 8; ++u) win[k][u] = 0.f; } else ld_bf8(PROJ + (size_t)(r0 - 3 + k) * PROJ_LD + PC_X + ch, win[k]); }
#pragma unroll
        for (int j = 0; j < 8; ++j) { float cur[8], o[8]; ld_bf8(PROJ + (size_t)(r0 + j) * PROJ_LD + PC_X + ch, cur);
#pragma unroll
            for (int u = 0; u < 8; ++u) { o[u] = silu(bias[u] + w[0][u] * win[0][u] + w[1][u] * win[1][u] + w[2][u] * win[2][u] + w[3][u] * cur[u]); win[0][u] = win[1][u]; win[1][u] = win[2][u]; win[2][u] = cur[u]; }
            st_bf8(XC + (size_t)(r0 + j) * 1024 + ch, o); }
    }
}
DEV void ssd_dtcum(const Ctx& ctx, PRM P, int l, const float* SMALL, int row0, int g, float* dt, float* cum, float* la) {
    for (int e = ctx.tid; e < 512; e += ctx.nthr) { const int h4 = e >> 7, i = e & 127, hd = g * 4 + h4; const float d = softplus(SMALL[(size_t)(row0 + i) * 32 + 16 + hd] + P.in[22][l * 8 + hd]);
        dt[e] = d; la[e] = d * -FEXP(P.in[23][l * 8 + hd]); }
    SYNC();
    for (int e = ctx.tid; e < 512; e += ctx.nthr) { const int i = e & 127, base = e - i; float run = 0.f; for (int u = 0; u <= i; ++u) run += la[base + u]; cum[e] = run; }
    SYNC();
}
DEV void ssd_a_item(const Ctx& ctx, PRM P, int l, int it, const bf16_t* XC, const float* SMALL, float* SST, float* SDEC) {
    const int b = it / (NC128 * 2), c = (it >> 1) % NC128, g = it & 1, row0 = b * SEQ + c * 128;
    float* dt = (float*)ctx.smem; float* cum = dt + 512; float* la = cum + 512; bf16_t* BT = (bf16_t*)(la + 512); bf16_t* xdT = BT + 128 * 136;
    ssd_dtcum(ctx, P, l, SMALL, row0, g, dt, cum, la);
    for (int e = ctx.tid; e < 2048; e += ctx.nthr) { const int i = e >> 4, n0 = (e & 15) * 8; const U4 w = *(const U4*)(XC + (size_t)(row0 + i) * 1024 + 512 + g * 128 + n0); bf16_t* bp = BT + n0 * 136 + i;
        bp[0] = (bf16_t)(w.x & 0xffff); bp[136] = (bf16_t)(w.x >> 16); bp[2 * 136] = (bf16_t)(w.y & 0xffff); bp[3 * 136] = (bf16_t)(w.y >> 16);
        bp[4 * 136] = (bf16_t)(w.z & 0xffff); bp[5 * 136] = (bf16_t)(w.z >> 16); bp[6 * 136] = (bf16_t)(w.w & 0xffff); bp[7 * 136] = (bf16_t)(w.w >> 16); }
    for (int e = ctx.tid; e < 4096; e += ctx.nthr) { const int i = e >> 5, q0 = (e & 31) * 8, h4 = q0 >> 6; float xv[8]; ld_bf8(XC + (size_t)(row0 + i) * 1024 + g * 256 + q0, xv);
        const float sc = dt[h4 * 128 + i] * FEXP(cum[h4 * 128 + 127] - cum[h4 * 128 + i]);
#pragma unroll
        for (int u = 0; u < 8; ++u) xdT[(q0 + u) * 136 + i] = f2bf(xv[u] * sc); }
    SYNC();
    float* st = SST + ((size_t)(b * 8 + g * 4) * NC128) * 8192;
    mm_nt(xdT, 136, BT, 136, 256, 128, 128, 0, ctx, [&](int i, int j, float v) { st[((size_t)(i >> 6) * NC128 + c) * 8192 + (i & 63) * 128 + j] = v; });
    for (int h4 = ctx.tid; h4 < 4; h4 += ctx.nthr) SDEC[(size_t)(b * 8 + g * 4 + h4) * NC128 + c] = FEXP(cum[h4 * 128 + 127]);
    SYNC();
}
DEV void phase_ssd_scan(const Ctx& ctx, float* SST, const float* SDEC) {
    const int total = SEQH * 8 * 8192;
    for (int idx = ctx.bid * ctx.nthr + ctx.tid; idx < total; idx += ctx.nblk * ctx.nthr) {
        const int bh = idx >> 13, e = idx & 8191; float* base = SST + (size_t)bh * NC128 * 8192 + e; const float* dec = SDEC + (size_t)bh * NC128; float run = 0.f;
        float la_[8], lb_[8];
#define SS_LOAD(L, c0) { _Pragma("unroll") for (int u = 0; u < 8; ++u) L[u] = base[(size_t)((c0) + u) * 8192]; }
#define SS_STEP(L, c0) { _Pragma("unroll") for (int u = 0; u < 8; ++u) { base[(size_t)((c0) + u) * 8192] = run; run = dec[(c0) + u] * run + L[u]; } }
        SS_LOAD(la_, 0);
        for (int c0 = 0; c0 < NC128; c0 += 16) { SS_LOAD(lb_, c0 + 8); SS_STEP(la_, c0); if (c0 + 16 < NC128) SS_LOAD(la_, c0 + 16); SS_STEP(lb_, c0 + 8); }
#undef SS_LOAD
#undef SS_STEP
    }
}
template <int M, int N, class F> DEV void mm_nt2(const bf16_t* A1, const bf16_t* B1, const float* rowscale, const bf16_t* A2, const bf16_t* B2, int ld, int K, const Ctx& ctx, F epi) {
    constexpr int ntn = N / 16, ntiles = (M / 16) * ntn;
#ifndef CPU_EMU
    const int wave = ctx.tid >> 6, lane = ctx.tid & 63, r = lane & 15, q = lane >> 4;
#pragma unroll
    for (int tt = 0; tt < ntiles / 8; ++tt) {
        const int t = wave + tt * 8, tm = t / ntn, tn = t % ntn; const int lim = (tm * 16 + 16 + 31) & ~31; const int kend = lim < K ? lim : K;
        f32x4 acc = {0.f, 0.f, 0.f, 0.f};
        const bf16_t* ap = A1 + (tm * 16 + r) * ld + q * 8; const bf16_t* bp = B1 + (tn * 16 + r) * ld + q * 8;
        for (int k0 = 0; k0 < K; k0 += 32) acc = __builtin_amdgcn_mfma_f32_16x16x32_bf16(*(const bf16x8*)(ap + k0), *(const bf16x8*)(bp + k0), acc, 0, 0, 0);
#pragma unroll
        for (int j = 0; j < 4; ++j) acc[j] *= rowscale[tm * 16 + q * 4 + j];
        ap = A2 + (tm * 16 + r) * ld + q * 8; bp = B2 + (tn * 16 + r) * ld + q * 8;
        for (int k0 = 0; k0 < kend; k0 += 32) acc = __builtin_amdgcn_mfma_f32_16x16x32_bf16(*(const bf16x8*)(ap + k0), *(const bf16x8*)(bp + k0), acc, 0, 0, 0);
#pragma unroll
        for (int j = 0; j < 4; ++j) epi(tm * 16 + q * 4 + j, tn * 16 + r, acc[j], tt * 4 + j);
    }
#else
    for (int t = 0; t < ntiles; ++t) {
        const int tm = t / ntn, tn = t % ntn; const int lim = (tm * 16 + 16 + 31) & ~31; const int kend = lim < K ? lim : K;
        for (int i = 0; i < 16; ++i) for (int j = 0; j < 16; ++j) { float s = 0; for (int k = 0; k < K; ++k) s += bf2f(A1[(tm * 16 + i) * ld + k]) * bf2f(B1[(tn * 16 + j) * ld + k]);
            s *= rowscale[tm * 16 + i]; for (int k = 0; k < kend; ++k) s += bf2f(A2[(tm * 16 + i) * ld + k]) * bf2f(B2[(tn * 16 + j) * ld + k]); epi(tm * 16 + i, tn * 16 + j, s, -1); }
    }
#endif
}
template <class F> DEV void mm_foreach(int M, int N, const Ctx& ctx, F f) {
    const int ntn = N / 16, ntiles = (M / 16) * ntn;
#ifndef CPU_EMU
    const int wave = ctx.tid >> 6, lane = ctx.tid & 63, nw = ctx.nthr >> 6, r = lane & 15, q = lane >> 4;
    for (int t = wave; t < ntiles; t += nw) { const int tm = t / ntn, tn = t % ntn;
#pragma unroll
        for (int j = 0; j < 4; ++j) f(tm * 16 + q * 4 + j, tn * 16 + r); }
#else
    for (int t = 0; t < ntiles; ++t) { const int tm = t / ntn, tn = t % ntn; for (int i = 0; i < 16; ++i) for (int j = 0; j < 16; ++j) f(tm * 16 + i, tn * 16 + j); }
#endif
}
DEV void ssd_c_item(const Ctx& ctx, PRM P, int l, int it, bf16_t* PROJ, const bf16_t* XC, const float* SMALL, const float* SST) {
    const int b = it / (NC128 * 2), c = (it >> 1) % NC128, g = it & 1, row0 = b * SEQ + c * 128;
    float* dt = (float*)ctx.smem; float* cum = dt + 512; float* la = cum + 512; u64* ssq = (u64*)(la + 512); float* ecum = (float*)(ssq + 128);
    bf16_t* Cs = (bf16_t*)(ecum + 128); bf16_t* Bs = Cs + 128 * 136; bf16_t* Sb = Bs + 128 * 136; bf16_t* xsT = Sb + 128 * 136; bf16_t* hin = xsT + 64 * 136; bf16_t* W = Bs;
    ssd_dtcum(ctx, P, l, SMALL, row0, g, dt, cum, la);
    for (int e = ctx.tid; e < 2048; e += ctx.nthr) { const int i = e >> 4, n0 = (e & 15) * 8; const bf16_t* src = XC + (size_t)(row0 + i) * 1024 + 512 + g * 128 + n0;
        *(U4*)(Bs + i * 136 + n0) = *(const U4*)src; *(U4*)(Cs + i * 136 + n0) = *(const U4*)(src + 256); }
    for (int i = ctx.tid; i < 128; i += ctx.nthr) ssq[i] = 0;
    SYNC();
    mm_nt(Cs, 136, Bs, 136, 128, 128, 128, 1, ctx, [&](int i, int j, float v) { Sb[i * 136 + j] = f2bf(v); });
    SYNC();
#ifndef CPU_EMU
    float yv[4][16];
    const int wave_ = ctx.tid >> 6, lane_ = ctx.tid & 63, r_ = lane_ & 15, q_ = lane_ >> 4;
#endif
#pragma unroll
    for (int h4 = 0; h4 < 4; ++h4) {
        const int hd = g * 4 + h4; const float* cm = cum + h4 * 128; const float* dth = dt + h4 * 128;
#ifndef CPU_EMU
        float zv[16];
#pragma unroll
        for (int tt = 0; tt < 4; ++tt) { const int t = wave_ + tt * 8, tm = t >> 2, tn = t & 3;
#pragma unroll
            for (int j = 0; j < 4; ++j) zv[tt * 4 + j] = bf2f(PROJ[(size_t)(row0 + tm * 16 + q_ * 4 + j) * PROJ_LD + PC_Z + hd * 64 + tn * 16 + r_]); }
#endif
        for (int e = ctx.tid; e < 2048; e += ctx.nthr) { const int i = e >> 4, m0 = (e & 15) * 8; const int lim = ((i & ~15) + 16 + 31) & ~31;
            if (m0 < lim) { float sv[8], wv[8]; ld_bf8(Sb + i * 136 + m0, sv); const float ci = cm[i];
#pragma unroll
                for (int u = 0; u < 8; ++u) { const int m = m0 + u; wv[u] = (m <= i) ? sv[u] * FEXP(ci - cm[m]) * dth[m] : 0.f; }
                st_bf8(W + i * 136 + m0, wv); } }
        for (int e = ctx.tid; e < 1024; e += ctx.nthr) { const int i = e >> 3, p0 = (e & 7) * 8; const U4 w = *(const U4*)(XC + (size_t)(row0 + i) * 1024 + hd * 64 + p0); bf16_t* bp = xsT + p0 * 136 + i;
            bp[0] = (bf16_t)(w.x & 0xffff); bp[136] = (bf16_t)(w.x >> 16); bp[2 * 136] = (bf16_t)(w.y & 0xffff); bp[3 * 136] = (bf16_t)(w.y >> 16);
            bp[4 * 136] = (bf16_t)(w.z & 0xffff); bp[5 * 136] = (bf16_t)(w.z >> 16); bp[6 * 136] = (bf16_t)(w.w & 0xffff); bp[7 * 136] = (bf16_t)(w.w >> 16); }
        const float* st = SST + ((size_t)(b * 8 + hd) * NC128 + c) * 8192;
        for (int e = ctx.tid; e < 1024; e += ctx.nthr) { const int p = e >> 4, n0 = (e & 15) * 8; float sv[8]; ld_f8(st + p * 128 + n0, sv); st_bf8(hin + p * 136 + n0, sv); }
        for (int i = ctx.tid; i < 128; i += ctx.nthr) ecum[i] = FEXP(cm[i]);
        SYNC();
        const float dsk = P.in[24][l * 8 + hd];
        mm_nt2<128, 64>(Cs, hin, ecum, W, xsT, 136, 128, ctx, [&](int i, int j, float v, int slot) {
#ifndef CPU_EMU
            const float y = bf2f(f2bf((v + dsk * bf2f(xsT[j * 136 + i])) * silu(zv[slot]))); yv[h4][slot] = y; LDS_ADD(&ssq[i], fx24(y * y));
#else
            bf16_t* zp = PROJ + (size_t)(row0 + i) * PROJ_LD + PC_Z + hd * 64 + j; const bf16_t yb = f2bf((v + dsk * bf2f(xsT[j * 136 + i])) * silu(bf2f(*zp)));
            *zp = yb; const float y = bf2f(yb); LDS_ADD(&ssq[i], fx24(y * y)); (void)slot;
#endif
        });
        SYNC();
    }
    const float* nw = P.in[25] + (size_t)l * 512 + g * 256;
#ifndef CPU_EMU
#pragma unroll
    for (int h4 = 0; h4 < 4; ++h4)
#pragma unroll
        for (int tt = 0; tt < 4; ++tt) { const int t = wave_ + tt * 8, tm = t >> 2, tn = t & 3;
#pragma unroll
            for (int j = 0; j < 4; ++j) { const int i = tm * 16 + q_ * 4 + j, col = h4 * 64 + tn * 16 + r_;
                PROJ[(size_t)(row0 + i) * PROJ_LD + PC_Z + g * 256 + col] = f2bf(yv[h4][tt * 4 + j] * (1.0f / sqrtf(unfx24(ssq[i]) * (1.0f / 256) + EPS)) * nw[col]); } }
#else
    for (int h4 = 0; h4 < 4; ++h4)
        mm_foreach(128, 64, ctx, [&](int i, int j) { bf16_t* zp = PROJ + (size_t)(row0 + i) * PROJ_LD + PC_Z + (g * 4 + h4) * 64 + j;
            *zp = f2bf(bf2f(*zp) * (1.0f / sqrtf(unfx24(ssq[i]) * (1.0f / 256) + EPS)) * nw[h4 * 64 + j]); });
#endif
    SYNC();
}

constexpr int PH_L0 = 20, PH_L1 = 20, PH_TOTAL = PH_L0 + PH_L1 + 1;
DEV void run_phase(const Ctx& ctx, PRM P, int ph) {
    unsigned char* ws = P.ws; unsigned* SSQ = (unsigned*)(ws + O_SSQ); unsigned char* osc = (unsigned char*)P.out;
    if (ph < 0) return;
    if (ph == PH_TOTAL - 1) { phase_final(ctx, (bf16_t*)(ws + O_HB), P.out, P.in[37], SSQ + (size_t)8 * T, T); return; }
    int l = 0, s = ph; if (ph >= PH_L0) { l = 1; s = ph - PH_L0; } if (s >= 1) s += 1;
    bf16_t* HB = (bf16_t*)(ws + (l == 0 ? O_HB : O_HB2)); bf16_t* HBN = (bf16_t*)(ws + (l == 0 ? O_HB2 : O_HB));
    unsigned* ssq1 = SSQ + (size_t)(l * 4 + 0) * T; unsigned* ssq2 = ssq1 + T; unsigned* ssq3 = ssq2 + T; unsigned* ssq4 = ssq3 + T; unsigned* ssq5 = ssq4 + T;
    if (s == 0) { phase_conv(ctx, P, l); if (l == 0) phase_norm(ctx, P.in[0], HB, ssq1, T); return; }
    if (s == 1) return;
    if (s == 2 || s == 18) { SchedSimple S; S.init(HB, D, (bf16_t*)(ws + (s == 2 ? W_GU1 : W_GU2)), D, T, NGU, D, ctx.nblk, ctx.bid); EpiSwiglu E{(bf16_t*)(ws + O_ACT), s == 2 ? ssq1 : ssq3}; gemm_phase(ctx, S, E); return; }
    if (s == 3 || s == 19) { SchedSimple S; S.init((bf16_t*)(ws + O_ACT), DFFP, (bf16_t*)(ws + (s == 3 ? W_D1 : W_D2)), DFFP, T, D, DFFP, ctx.nblk, ctx.bid); EpiResid E{HB, HB, 0.5f, s == 3 ? ssq2 : ssq4}; gemm_phase(ctx, S, E); return; }
    if (s == 20) { SchedPle S{(bf16_t*)(ws + O_PB), (bf16_t*)(ws + W_PP), HB, (bf16_t*)(ws + W_PG), (T / 256) * 4, ctx.nblk, ctx.bid}; EpiPle E{HB, (bf16_t*)(ws + O_PP), HBN, ssq4, ssq5}; gemm_phase(ctx, S, E); return; }
    const int half = (s - 4) / 7, lv = (s - 4) % 7;
    bf16_t* HBh = HB + (size_t)half * TH * D;
    bf16_t* PROJ = (bf16_t*)(ws + O_PROJ); float* SMALL = (float*)(ws + O_SMALL); bf16_t* XS = (bf16_t*)(ws + O_XS); float* S5S = (float*)(ws + O_S5S);
    bf16_t* GS5 = (bf16_t*)(osc + OUT_GS5); bf16_t* YS5 = (bf16_t*)(osc + OUT_YS5); bf16_t* GATES = (bf16_t*)(osc + OUT_GATES); float* GST = (float*)(ws + O_GST); float* GDEC = (float*)(ws + O_GDEC);
    float* SST = (float*)(ws + O_SST); float* SDEC = (float*)(ws + O_SDEC); bf16_t* SG = (bf16_t*)(ws + O_SG); bf16_t* MG = (bf16_t*)(ws + O_MG);
    if (lv == 0) { SchedSimple S; S.init(HBh, D, (bf16_t*)(ws + W_IN), D, TH, IN_N + 3072, D, ctx.nblk, ctx.bid); EpiWin E{XS, PROJ, SMALL, GATES, ssq2 + (size_t)half * TH}; gemm_phase(ctx, S, E); return; }
    bf16_t* XC = (bf16_t*)(ws + O_SG);
    if (lv == 1) {
        { SchedS5 S{XS, (bf16_t*)(ws + W_S1), 256, CHH / 256, ctx.nblk, ctx.bid}; EpiS5P1 E{S5S}; gemm_phase(ctx, S, E); }
        phase_ssd_conv(ctx, P, l, PROJ, XC);
        for (int it = ctx.bid; it < SEQH * NC64 * 4; it += ctx.nblk) gla_a_item(ctx, P, l, it, PROJ, SMALL, GST, GDEC, (float*)(ws + O_BCG));
        return; }
    if (lv == 2) { for (int it = ctx.bid; it < SEQH * NC128 * 2; it += ctx.nblk) ssd_a_item(ctx, P, l, it, XC, SMALL, SST, SDEC);
        phase_s5scan(ctx, XS, S5S, (const float*)(ws + W_LAM)); phase_gla_scan(ctx, GST, GDEC); return; }
    if (lv == 3) {
        { SchedS5 S{XS, (bf16_t*)(ws + W_S3), 384, CHH / 256, ctx.nblk, ctx.bid}; EpiS5P3 E{GS5}; gemm_phase(ctx, S, E); }
        phase_ssd_scan(ctx, SST, SDEC);
        for (int it = ctx.bid; it < SEQH * NC64 * 4; it += ctx.nblk) gla_c_item(ctx, P, l, it, PROJ, (const float*)(ws + O_BCG), GST);
        return; }
    if (lv == 4) { { SchedSimple S; S.init(GS5, 512, (bf16_t*)(ws + W_GLU), 512, TH, 512, 512, ctx.nblk, ctx.bid); EpiGlu E{GS5, YS5}; gemm_phase(ctx, S, E); }
        for (int it = ctx.bid; it < SEQH * NC128 * 2; it += ctx.nblk) ssd_c_item(ctx, P, l, it, PROJ, XC, SMALL, SST); return; }
    if (lv == 5) { SchedMerge S{(bf16_t*)(ws + W_BR), YS5, PROJ, (TH / 256) * 4, ctx.nblk, ctx.bid}; EpiMerge E{GATES, MG}; gemm_phase(ctx, S, E); return; }
    if (lv == 6) { SchedSimple S; S.init(MG, D, (bf16_t*)(ws + W_OUT), D, TH, D, D, ctx.nblk, ctx.bid); EpiResid E{HBh, HBh, 1.0f, ssq3 + (size_t)half * TH}; gemm_phase(ctx, S, E); return; }
}

#ifndef CPU_EMU
#define XB_TMO      128
#define XB_XCNT(j)  (256  + 64 * (j))
#define XB_XSUB(j)  (1280 + 64 * (j))
#define XB_XGEN(j)  (2304 + 64 * (j))
#define XB_TOP      3328
#define XB_TOPGEN   3392
#define XCD_BAR_WORDS 3456
#define XB_SPIN_CAP (1u << 18)
__device__ __forceinline__ unsigned xb_ld(unsigned* p)              { return __hip_atomic_load(p, __ATOMIC_RELAXED, __HIP_MEMORY_SCOPE_AGENT); }
__device__ __forceinline__ unsigned xb_add(unsigned* p, unsigned v) { return __hip_atomic_fetch_add(p, v, __ATOMIC_RELAXED, __HIP_MEMORY_SCOPE_AGENT); }
__device__ __forceinline__ unsigned xb_xcc_id() { return (unsigned)__builtin_amdgcn_s_getreg((3 << 11) | 20) & 0xFu; }
#define XB_SPIN(cond, bar) do { unsigned _sp = 0; while (cond) { __builtin_amdgcn_s_sleep(1); \
    if ((++_sp & 255u) == 0u) { if (xb_ld(&(bar)[XB_TMO])) break; if (_sp > XB_SPIN_CAP) { atomicAdd(&(bar)[XB_TMO], 1u); break; } } } } while (0)
struct XcdBarrier { unsigned* bar; unsigned x; volatile LAS unsigned* st; };
__device__ __forceinline__ XcdBarrier xcd_barrier_post(unsigned* bar, volatile LAS unsigned* st) {
    XcdBarrier b; b.bar = bar; b.x = xb_xcc_id(); b.st = st;
    if (threadIdx.x == 0) (void)xb_add(&bar[XB_XCNT(b.x)], 1u);
    return b;
}
__device__ __forceinline__ void xcd_barrier_complete(unsigned* bar, unsigned x, unsigned& nloc, unsigned& nx) {
    const unsigned G = gridDim.x * gridDim.y * gridDim.z;
    unsigned sum, cnt, mine, sp = 0u;
    for (;;) {
        sum = 0u; cnt = 0u; mine = 0u;
#pragma unroll
        for (unsigned j = 0; j < 16; ++j) { const unsigned c = xb_ld(&bar[XB_XCNT(j)]); sum += c; cnt += (c > 0u) ? 1u : 0u; mine = (j == x) ? c : mine; }
        if (sum == G) break;
        __builtin_amdgcn_s_sleep(1);
        if ((++sp & 255u) == 0u) { if (xb_ld(&bar[XB_TMO])) break; if (sp > XB_SPIN_CAP) { atomicAdd(&bar[XB_TMO], 1u); break; } }
    }
    nloc = mine > 0u ? mine : 1u; nx = cnt > 0u ? cnt : 1u;
}
__device__ __forceinline__ void xcd_barrier(const XcdBarrier& b) {
    asm volatile("s_waitcnt vmcnt(0)" ::: "memory");
    __syncthreads();
    if (threadIdx.x == 0) {
        unsigned* bar = b.bar;
        __builtin_amdgcn_s_waitcnt(0);
        unsigned nloc = b.st[0], nx = b.st[1];
        if (nloc == 0u) { xcd_barrier_complete(bar, b.x, nloc, nx); b.st[0] = nloc; b.st[1] = nx; }
        const unsigned old = xb_add(&bar[XB_XSUB(b.x)], 1u);
        const unsigned gen = old / nloc;
        if (old + 1u == (gen + 1u) * nloc) {
            __builtin_amdgcn_fence(__ATOMIC_RELEASE, "agent");
            asm volatile("s_waitcnt vmcnt(0)" ::: "memory");
            const unsigned og = xb_add(&bar[XB_TOP], 1u);
            const unsigned tg = og / nx;
            if (og + 1u == (tg + 1u) * nx) xb_add(&bar[XB_TOPGEN], 1u);
            else XB_SPIN(xb_ld(&bar[XB_TOPGEN]) == tg, bar);
            __builtin_amdgcn_fence(__ATOMIC_ACQUIRE, "agent");
            xb_add(&bar[XB_XGEN(b.x)], 1u);
            asm volatile("s_waitcnt vmcnt(0)" ::: "memory");
        } else {
            XB_SPIN(xb_ld(&bar[XB_XGEN(b.x)]) == gen, bar);
            __builtin_amdgcn_fence(__ATOMIC_ACQUIRE, "agent");
            asm volatile("s_waitcnt vmcnt(0)" ::: "memory");
        }
    }
    __syncthreads();
}

__global__ void __launch_bounds__(512) hybrid_megakernel(Params P) {
        extern __shared__ __attribute__((aligned(16))) unsigned char smem[];
    volatile LAS unsigned* xst = (volatile LAS unsigned*)(smem + LDS_BYTES);
    if (threadIdx.x == 0) { xst[0] = 0u; xst[1] = 0u; xst[2] = 0u; xst[3] = 0u; }
    __syncthreads();
    (void)xcd_barrier_post((unsigned*)(P.ws + O_BAR), xst);
#define GRID_SYNC(first) do { if ((first) && Pp->ws == nullptr) cg::this_grid().sync(); else { XcdBarrier xb_; xb_.bar = (unsigned*)(Pp->ws + O_BAR); xb_.x = xb_xcc_id(); xb_.st = (volatile LAS unsigned*)(smem + LDS_BYTES); xcd_barrier(xb_); } } while (0)
#define STEP(n) { const __attribute__((address_space(4))) Params* Pp = (const __attribute__((address_space(4))) Params*)__builtin_amdgcn_kernarg_segment_ptr(); \
        int tid = threadIdx.x, bid = blockIdx.x, nblk = gridDim.x, smo = 0; \
        asm volatile("" : "+s"(Pp), "+v"(tid), "+s"(bid), "+s"(nblk), "+s"(smo)); \
        Ctx ctx; ctx.bid = bid; ctx.nblk = nblk; ctx.tid = tid; ctx.nthr = 512; ctx.smem = smem + smo; \
        run_phase(ctx, *Pp, (n)); \
        if ((n) + 1 < PH_TOTAL + REP_N) GRID_SYNC((n) == 0); }
#ifndef REP_N
#define REP_N 0
#define REP_PH 0
#endif
    STEP(0) STEP(1) STEP(2) STEP(3) STEP(4) STEP(5) STEP(6) STEP(7) STEP(8) STEP(9) STEP(10) STEP(11) STEP(12) STEP(13) STEP(14) STEP(15) STEP(16) STEP(17) STEP(18) STEP(19) STEP(20)
    STEP(21) STEP(22) STEP(23) STEP(24) STEP(25) STEP(26) STEP(27) STEP(28) STEP(29) STEP(30) STEP(31) STEP(32) STEP(33) STEP(34) STEP(35) STEP(36) STEP(37) STEP(38) STEP(39) STEP(40)
    static_assert(PH_TOTAL == 41, "update the unrolled phase list");
#if REP_N > 0
    for (int r = 0; r < REP_N; ++r) { const __attribute__((address_space(4))) Params* Pp = (const __attribute__((address_space(4))) Params*)__builtin_amdgcn_kernarg_segment_ptr();
        int tid = threadIdx.x, bid = blockIdx.x, nblk = gridDim.x, smo = 0;
        asm volatile("" : "+s"(Pp), "+v"(tid), "+s"(bid), "+s"(nblk), "+s"(smo));
        Ctx ctx; ctx.bid = bid; ctx.nblk = nblk; ctx.tid = tid; ctx.nthr = 512; ctx.smem = smem + smo;
        run_phase(ctx, *Pp, REP_PH);
        if (r + 1 < REP_N) GRID_SYNC(false); }
#endif
}
#endif

#ifndef CPU_EMU
extern "C" void kernel_launch(void* const* d_in, const int* in_sizes, int n_in, void* d_out, int out_size, void* d_ws, size_t ws_size, hipStream_t stream) {
    static int grid_blocks = 0;
    if (grid_blocks == 0) {
        if (n_in != 38 || ws_size < WS_NEED) { fprintf(stderr, "kernel_launch: need 38 inputs and %zu bytes of workspace (got %d, %zu)\n", (size_t)WS_NEED, n_in, ws_size); grid_blocks = -1; return; }
        int dev = 0, cus = 0, per_cu = 0;
        hipGetDevice(&dev);
        hipDeviceGetAttribute(&cus, hipDeviceAttributeMultiprocessorCount, dev);
        hipFuncSetAttribute((const void*)hybrid_megakernel, hipFuncAttributeMaxDynamicSharedMemorySize, LDS_TOTAL);
        hipOccupancyMaxActiveBlocksPerMultiprocessor(&per_cu, (const void*)hybrid_megakernel, 512, LDS_TOTAL);
        if (per_cu < 1) per_cu = 1;
        grid_blocks = cus * 1;
        (void)hipGetLastError();
    }
    if (grid_blocks < 0) return;
    Params P{};
    for (int i = 0; i < 38; ++i) P.in[i] = (const float*)d_in[i];
    P.out = (float*)d_out; P.ws = (unsigned char*)d_ws;
    (void)hipMemsetAsync((unsigned char*)d_ws + O_BAR, 0, 16384, stream);
    void* args[] = {&P};
    hipError_t e = hipLaunchCooperativeKernel((const void*)hybrid_megakernel, dim3(grid_blocks), dim3(512), args, LDS_TOTAL, stream);
    if (e != hipSuccess) fprintf(stderr, "cooperative launch failed: %s (grid %d)\n", hipGetErrorString(e), grid_blocks);
}
#endif
```

```cpp
#ifndef CPU_EMU
#include <hip/hip_runtime.h>
#include <hip/hip_cooperative_groups.h>
namespace cg = cooperative_groups;
#define DEV __device__ __forceinline__
#define SYNC() __syncthreads()
#else
#include <cmath>
#include <cstring>
#include <cstdio>
#include <cstdlib>
#define DEV inline
#define SYNC() do {} while (0)
#endif

typedef unsigned short bf16_t;

#ifndef EMU_BATCH
#define EMU_BATCH 8
#define EMU_SEQ 4096
#endif
constexpr int BATCH = EMU_BATCH, SEQ = EMU_SEQ, DEPTH = 2;
constexpr int D = 1024, DFF = 2752, DFFP = 2816, NGU = 5632, PLE = 256;
constexpr int T = BATCH * SEQ, TH = T / 2, SEQH = BATCH / 2;
constexpr int NC64 = SEQ / 64, NC128 = SEQ / 128, NCH16 = SEQ / 16, CHH = TH / 16;
constexpr int PROJ_LD = 3072, IN_N = 3840, IN_TOTAL = 6680;
constexpr int PC_Q = 0, PC_K = 256, PC_V = 512, PC_GO = 1024, PC_Z = 1536, PC_X = 2048;
constexpr float EPS = 1e-6f;

constexpr size_t al256(size_t x) { return (x + 255) & ~(size_t)255; }
constexpr size_t SZ_GU = (size_t)NGU * D * 2, SZ_DN = (size_t)D * DFFP * 2;
constexpr size_t W_GU1 = 0, W_D1 = W_GU1 + SZ_GU, W_GU2 = W_D1 + SZ_DN, W_D2 = W_GU2 + SZ_GU;
constexpr size_t W_IN = W_D2 + SZ_DN, W_G = W_IN + (size_t)IN_N * D * 2, W_GLU = W_G + (size_t)3072 * D * 2;
constexpr size_t W_BR = W_GLU + (size_t)512 * 512 * 2, W_OUT = W_BR + (size_t)3 * 1024 * 512 * 2, W_PG = W_OUT + (size_t)D * D * 2;
constexpr size_t W_PP = W_PG + (size_t)D * D * 2, W_S1 = W_PP + (size_t)D * PLE * 2, W_S3 = W_S1 + (size_t)32 * 256 * 256 * 2;
constexpr size_t W_LAM = W_S3 + (size_t)32 * 256 * 384 * 2, W_END = al256(W_LAM + 32 * 64 * 2 * 4);
constexpr size_t O_HB = W_END, O_HB2 = O_HB + (size_t)T * D * 2, O_SSQ = O_HB2 + (size_t)T * D * 2, O_PB = O_SSQ + (size_t)9 * T * 4, O_BIG = O_PB + (size_t)T * PLE * 2;
constexpr size_t O_ACT = O_BIG;
constexpr size_t O_PP = O_BIG;
constexpr size_t O_PROJ = O_BIG, O_SMALL = O_PROJ + (size_t)TH * PROJ_LD * 2, O_XS = O_SMALL + (size_t)TH * 32 * 4;
constexpr size_t O_S5S = O_XS + (size_t)CHH * 32 * 384 * 2, O_GST = O_S5S + (size_t)CHH * 32 * 128 * 4,
    OUT_GATES = 0, OUT_GS5 = (size_t)TH * 3072 * 2, OUT_YS5 = OUT_GS5 + (size_t)TH * 512 * 2;
constexpr size_t O_GDEC = O_GST + (size_t)SEQH * 4 * NC64 * 8192 * 4;
constexpr size_t O_SST = al256(O_GDEC + (size_t)SEQH * 4 * NC64 * 64 * 4), O_SDEC = O_SST + (size_t)SEQH * 8 * NC128 * 8192 * 4;
constexpr size_t O_BCG = al256(O_SDEC + (size_t)SEQH * 8 * NC128 * 4), O_SG = O_BCG + (size_t)SEQH * 4 * NC64 * 4096 * 4, O_MG = O_SG + (size_t)TH * D * 2, O_MIXEND = O_MG + (size_t)TH * D * 2;
constexpr size_t O_FFNEND = O_ACT + (size_t)T * DFFP * 2, O_PLEEND = O_PP + (size_t)T * D * 2;
constexpr size_t WS_NEED0 = (O_MIXEND > O_FFNEND ? (O_MIXEND > O_PLEEND ? O_MIXEND : O_PLEEND) : (O_FFNEND > O_PLEEND ? O_FFNEND : O_PLEEND));
constexpr size_t O_BAR = al256(WS_NEED0), WS_NEED = O_BAR + 16384;
constexpr int LDS_BYTES = 144 * 1024, LDS_TOTAL = LDS_BYTES + 16;

struct Params {
    const float* in[38];
    float* out;
    unsigned char* ws;
};
struct Ctx { int bid, nblk, tid, nthr; unsigned char* smem; };
#ifndef CPU_EMU
#define PRM const __attribute__((address_space(4))) Params&
#else
#define PRM const Params&
#endif

union FU { float f; unsigned u; };
DEV float bf2f(bf16_t b) { FU x; x.u = ((unsigned)b) << 16; return x.f; }
DEV bf16_t f2bf(float f) { FU x; x.f = f; unsigned u = x.u; u += 0x7FFFu + ((u >> 16) & 1u); return (bf16_t)(u >> 16); }
DEV unsigned pack2(float lo, float hi) { return (unsigned)f2bf(lo) | ((unsigned)f2bf(hi) << 16); }
#ifndef CPU_EMU
#define FEXP(x) __expf(x)
#define FLOG(x) __logf(x)
#define FRCP(x) __frcp_rn(x)
#define LDS_ADD(p, v) atomicAdd((p), (v))
#else
#define FEXP(x) expf(x)
#define FLOG(x) logf(x)
#define FRCP(x) (1.0f / (x))
#define LDS_ADD(p, v) (*(p) += (v))
#endif
typedef unsigned long long u64;
DEV u64 fx24(float v) { return (u64)(v * 16777216.0f + 0.5f); }
DEV float unfx24(u64 v) { return (float)v * (1.0f / 16777216.0f); }
DEV float sigm(float x) { return FRCP(1.f + FEXP(-x)); }
DEV float silu(float x) { return x * FRCP(1.f + FEXP(-x)); }
DEV float softplus(float x) { return x > 20.f ? x : FLOG(1.f + FEXP(x)); }
DEV float logsig(float x) { return fminf(x, 0.f) - FLOG(1.f + FEXP(-fabsf(x))); }
DEV float gelu_t(float x) { const float u = 0.7978845608f * (x + 0.044715f * x * x * x); return x * FRCP(1.f + FEXP(-2.f * u)); }
struct alignas(16) U4 { unsigned x, y, z, w; };
struct alignas(16) F4 { float x, y, z, w; };
DEV void st_bf8(bf16_t* p, const float* v) { U4 w; w.x = pack2(v[0], v[1]); w.y = pack2(v[2], v[3]); w.z = pack2(v[4], v[5]); w.w = pack2(v[6], v[7]); *(U4*)p = w; }
DEV void ld_bf8(const bf16_t* p, float* v) { U4 w = *(const U4*)p; v[0] = bf2f((bf16_t)(w.x & 0xffff)); v[1] = bf2f((bf16_t)(w.x >> 16)); v[2] = bf2f((bf16_t)(w.y & 0xffff)); v[3] = bf2f((bf16_t)(w.y >> 16));
    v[4] = bf2f((bf16_t)(w.z & 0xffff)); v[5] = bf2f((bf16_t)(w.z >> 16)); v[6] = bf2f((bf16_t)(w.w & 0xffff)); v[7] = bf2f((bf16_t)(w.w >> 16)); }
DEV void up_bf8(U4 w, float* v) { v[0] = bf2f((bf16_t)(w.x & 0xffff)); v[1] = bf2f((bf16_t)(w.x >> 16)); v[2] = bf2f((bf16_t)(w.y & 0xffff)); v[3] = bf2f((bf16_t)(w.y >> 16));
    v[4] = bf2f((bf16_t)(w.z & 0xffff)); v[5] = bf2f((bf16_t)(w.z >> 16)); v[6] = bf2f((bf16_t)(w.w & 0xffff)); v[7] = bf2f((bf16_t)(w.w >> 16)); }
DEV void st_f8(float* p, const float* v) { F4 a, b; a.x = v[0]; a.y = v[1]; a.z = v[2]; a.w = v[3]; b.x = v[4]; b.y = v[5]; b.z = v[6]; b.w = v[7]; *(F4*)p = a; *(F4*)(p + 4) = b; }
DEV void ld_f8(const float* p, float* v) { F4 a = *(const F4*)p, b = *(const F4*)(p + 4); v[0] = a.x; v[1] = a.y; v[2] = a.z; v[3] = a.w; v[4] = b.x; v[5] = b.y; v[6] = b.z; v[7] = b.w; }

struct Unit { const bf16_t* A; const bf16_t* B; int lda, ldb, nt, pm, pn, sub; };

struct SchedSimple {
    const bf16_t* A; const bf16_t* Bt; int lda, ldb, K, nM, nN, nwg, G, c;
    DEV void init(const bf16_t* A_, int lda_, const bf16_t* Bt_, int ldb_, int M, int N, int K_, int G_, int c_) { A = A_; Bt = Bt_; lda = lda_; ldb = ldb_; K = K_; nM = M / 256; nN = N / 256; nwg = nM * nN; G = G_; c = c_; }
    DEV bool next(int i, Unit& u) const {
        const long L = (long)i * G + c; if (L >= nwg) return false;
        int wgid = (int)L; { const int q = nwg / 8, r = nwg % 8, xcd = wgid % 8, off = wgid / 8; wgid = (xcd < r ? xcd * (q + 1) : r * (q + 1) + (xcd - r) * q) + off; }
        const int nig = 8 * nN, gid = wgid / nig, fm = gid * 8, gsz = (nM - fm) < 8 ? (nM - fm) : 8;
        u.pm = fm + ((wgid % nig) % gsz); u.pn = (wgid % nig) / gsz; u.sub = 0;
        u.A = A + (size_t)u.pm * 256 * lda; u.B = Bt + (size_t)u.pn * 256 * ldb; u.lda = lda; u.ldb = ldb; u.nt = K / 64; return true;
    }
};
struct SchedS5 {
    const bf16_t* XS; const bf16_t* Bt; int K, nM, G, c;
    DEV bool next(int i, Unit& u) const {
        const int L = i * G + c; if (L >= nM * 32) return false;
        u.pm = L / 32; u.sub = L % 32; u.pn = 0;
        u.A = XS + (size_t)u.pm * 256 * (32 * 384) + u.sub * 384; u.lda = 32 * 384; u.B = Bt + (size_t)u.sub * 256 * K; u.ldb = K; u.nt = K / 64; return true;
    }
};
struct SchedMerge {
    const bf16_t* WBR; const bf16_t* YS5; const bf16_t* PROJ; int ntiles, G, c;
    DEV bool next(int i, Unit& u) const {
        const int tl = (i / 3) * G + c; if (tl >= ntiles) return false;
        const int k = i % 3; const int x = tl % 8, idx = tl / 8;
        u.pm = x * (ntiles / 32) + idx / 4; u.pn = idx % 4; u.sub = k;
        if (k == 0) { u.A = YS5 + (size_t)u.pm * 256 * 512; u.lda = 512; } else { u.A = PROJ + (size_t)u.pm * 256 * PROJ_LD + (k == 1 ? PC_GO : PC_Z); u.lda = PROJ_LD; }
        u.B = WBR + ((size_t)k * 1024 + u.pn * 256) * 512; u.ldb = 512; u.nt = 8;
        return true;
    }
};

DEV unsigned ssq_fix(float ss) { return (unsigned)(ss * 16384.0f + 0.5f); }
DEV float rstd_of(float raw) { FU x; x.f = raw; return 1.0f / sqrtf((float)x.u * (1.0f / (16384.0f * D)) + EPS); }
DEV float ssq_raw(const unsigned* p) { FU x; x.u = *p; return x.f; }
struct EpiSwiglu { static constexpr bool GU = true, SSQ = false, RV = true, PF = false; bf16_t* act; const unsigned* ssq_in;
    DEV float rowval(const Unit&, int row) const { return ssq_raw(ssq_in + row); }
    DEV void store_gu(const Unit&, int row, int hid, const float* g, const float* u, float rv) const { const float r = rstd_of(rv); float v[8]; for (int i = 0; i < 8; ++i) v[i] = silu(g[i] * r) * (u[i] * r); st_bf8(act + (size_t)row * DFFP + hid, v); } };
struct EpiResid { static constexpr bool GU = false, SSQ = true, RV = false, PF = true; const bf16_t* hb_src; bf16_t* hb_dst; float scale; unsigned* ssq;
    DEV float rowval(const Unit&, int) const { return 0.f; }
    DEV void prefetch(const Unit&, int row, int col, U4& a, U4& b, float& c) const { a = *(const U4*)(hb_src + (size_t)row * D + col); b = a; c = 0.f; }
    DEV float store8p(const Unit&, int row, int col, const float* v, float, const U4& a, const U4&, float) const { float s[8], o[8], ss = 0.f; up_bf8(a, s);
        for (int i = 0; i < 8; ++i) { o[i] = bf2f(f2bf(s[i] + scale * v[i])); ss += o[i] * o[i]; }
        st_bf8(hb_dst + (size_t)row * D + col, o); return ss; }
    DEV float store8(const Unit& u, int row, int col, const float* v, float rv) const { U4 a, b; float c; prefetch(u, row, col, a, b, c); return store8p(u, row, col, v, rv, a, b, c); } };
struct EpiWin { static constexpr bool GU = false, SSQ = false, RV = true, PF = false; bf16_t* XS; bf16_t* PROJ; float* SMALL; bf16_t* GATES; const unsigned* ssq_in;
    DEV float rowval(const Unit&, int row) const { return ssq_raw(ssq_in + row); }
    DEV void store8(const Unit& u, int row, int col, const float* vin, float rv) const { const float r = rstd_of(rv); float v[8]; for (int i = 0; i < 8; ++i) v[i] = vin[i] * r;
        if (u.pn < 2) st_bf8(XS + ((size_t)(row >> 4) * 32 + (col >> 4)) * 384 + (row & 15) * 16 + (col & 15), v);
        else if (u.pn < 14) st_bf8(PROJ + (size_t)row * PROJ_LD + (col - 512), v);
        else if (u.pn == 14) { const int c = col - 3584; if (c < 32) st_f8(SMALL + (size_t)row * 32 + c, v); }
        else { float t[8]; for (int i = 0; i < 8; ++i) t[i] = sigm(v[i]); st_bf8(GATES + (size_t)row * 3072 + (col - 3840), t); } } };
struct EpiS5P1 { static constexpr bool GU = false, SSQ = false, RV = false, PF = false; float* S5S;
    DEV float rowval(const Unit&, int) const { return 0.f; }
    DEV void store8(const Unit& u, int row, int col, const float* v, float) const { if (col < 128) st_f8(S5S + ((size_t)row * 32 + u.sub) * 128 + col, v); } };
struct EpiS5P3 { static constexpr bool GU = false, SSQ = false, RV = false, PF = false; bf16_t* GS5;
    DEV float rowval(const Unit&, int) const { return 0.f; }
    DEV void store8(const Unit& u, int row, int col, const float* v, float) const { float o[8]; for (int i = 0; i < 8; ++i) o[i] = gelu_t(v[i]); st_bf8(GS5 + ((size_t)row * 16 + (col >> 4)) * 512 + u.sub * 16 + (col & 15), o); } };
struct EpiGlu { static constexpr bool GU = false, SSQ = false, RV = false, PF = true; const bf16_t* GS5; bf16_t* YS5;
    DEV float rowval(const Unit&, int) const { return 0.f; }
    DEV void prefetch(const Unit&, int row, int col, U4& a, U4& b, float& c) const { a = *(const U4*)(GS5 + (size_t)row * 512 + col); b = a; c = 0.f; }
    DEV float store8p(const Unit&, int row, int col, const float* v, float, const U4& a, const U4&, float) const { float g[8], o[8]; up_bf8(a, g); for (int i = 0; i < 8; ++i) o[i] = g[i] * sigm(v[i]); st_bf8(YS5 + (size_t)row * 512 + col, o); return 0.f; }
    DEV void store8(const Unit& u, int row, int col, const float* v, float rv) const { U4 a, b; float c; prefetch(u, row, col, a, b, c); (void)store8p(u, row, col, v, rv, a, b, c); } };
struct EpiMerge { static constexpr bool GU = false, SSQ = false, RV = false, PF = true; const bf16_t* GATES; bf16_t* MG;
    DEV float rowval(const Unit&, int) const { return 0.f; }
    DEV void prefetch(const Unit& u, int row, int col, U4& a, U4& b, float& c) const { a = *(const U4*)(GATES + (size_t)row * 3072 + u.sub * 1024 + col);
        if (u.sub == 0) { b.x = b.y = b.z = b.w = 0u; } else b = *(const U4*)(MG + (size_t)row * D + col); c = 0.f; }
    DEV float store8p(const Unit&, int row, int col, const float* v, float, const U4& a, const U4& b, float) const { float g[8], m[8], t[8]; up_bf8(a, g); up_bf8(b, m);
        for (int i = 0; i < 8; ++i) t[i] = m[i] + g[i] * v[i]; st_bf8(MG + (size_t)row * D + col, t); return 0.f; }
    DEV void store8(const Unit& u, int row, int col, const float* v, float rv) const { U4 a, b; float c; prefetch(u, row, col, a, b, c); (void)store8p(u, row, col, v, rv, a, b, c); } };
struct EpiBf { static constexpr bool GU = false, SSQ = false, RV = false, PF = false; bf16_t* O; int ld;
    DEV float rowval(const Unit&, int) const { return 0.f; }
    DEV void store8(const Unit&, int row, int col, const float* v, float) const { st_bf8(O + (size_t)row * ld + col, v); } };
struct EpiPle { static constexpr bool GU = false, SSQ = true, RV = false, PF = true; const bf16_t* hb_src; bf16_t* PPb; bf16_t* hb_dst; const unsigned* ssq_in; unsigned* ssq;
    DEV float rowval(const Unit&, int) const { return 0.f; }
    DEV void prefetch(const Unit& u, int row, int col, U4& a, U4& b, float& c) const { const size_t off = (size_t)row * D + col;
        if (u.sub == 0) { a.x = a.y = a.z = a.w = 0u; b = a; c = 0.f; } else { a = *(const U4*)(hb_src + off); b = *(const U4*)(PPb + off); c = ssq_raw(ssq_in + row); } }
    DEV float store8p(const Unit& u, int row, int col, const float* v, float, const U4& a, const U4& b, float c) const { const size_t off = (size_t)row * D + col;
        if (u.sub == 0) { st_bf8(PPb + off, v); return 0.f; }
        const float r = rstd_of(c); float s[8], p[8], o[8], ss = 0.f; up_bf8(a, s); up_bf8(b, p); for (int i = 0; i < 8; ++i) { o[i] = bf2f(f2bf(s[i] + sigm(v[i] * r) * p[i])); ss += o[i] * o[i]; }
        st_bf8(hb_dst + off, o); return ss; }
    DEV float store8(const Unit& u, int row, int col, const float* v, float rv) const { U4 a, b; float c; prefetch(u, row, col, a, b, c); return store8p(u, row, col, v, rv, a, b, c); } };
struct SchedPle { const bf16_t* PB; const bf16_t* WPP; const bf16_t* HB; const bf16_t* WPG; int ntiles, G, c;
    DEV bool next(int i, Unit& u) const {
        const int tl = (i >> 1) * G + c; if (tl >= ntiles) return false;
        u.sub = i & 1; u.pm = tl >> 2; u.pn = tl & 3;
        if (u.sub == 0) { u.A = PB + (size_t)u.pm * 256 * PLE; u.lda = PLE; u.B = WPP + (size_t)u.pn * 256 * PLE; u.ldb = PLE; u.nt = PLE / 64; }
        else { u.A = HB + (size_t)u.pm * 256 * D; u.lda = D; u.B = WPG + (size_t)u.pn * 256 * D; u.ldb = D; u.nt = D / 64; }
        return true; } };

#ifndef CPU_EMU
#define LAS __attribute__((address_space(3)))
typedef short bf16x8 __attribute__((ext_vector_type(8)));
typedef float f32x4 __attribute__((ext_vector_type(4)));
constexpr int HTB = 128 * 64 * 2;
__device__ __forceinline__ int lds_byte(int r, int c) { const int st = (r >> 4) * 2 + (c >> 5), rr = r & 15, cc = c & 31, ob = rr * 64 + cc * 2; return st * 1024 + (ob ^ (((ob >> 9) & 1) << 5)); }
__device__ __forceinline__ void stage_rc(int b, int& R, int& C) { const int st = b / 1024, sb = b % 1024, swz = sb ^ (((sb >> 9) & 1) << 5); R = (st >> 1) * 16 + swz / 64; C = (st & 1) * 32 + (swz % 64) / 2; }
__device__ __forceinline__ int perm32(int rho) { const int n = rho >> 4, i = rho & 15; return 8 * (i >> 2) + 4 * n + (i & 3); }

template <class E> __device__ __forceinline__ void epi_apply(const E& e, const f32x4 (&acc)[2][2][4][2], const Unit& u, int wr, int wc, int fr, int fq, const float (&rs)[8]) {
    if constexpr (E::GU) {
#pragma unroll
        for (int ai = 0; ai < 2; ++ai)
#pragma unroll
            for (int m = 0; m < 4; ++m) { const int row = u.pm * 256 + ai * 128 + wr * 64 + m * 16 + fr; float g[8], uu[8];
#pragma unroll
                for (int j = 0; j < 4; ++j) { g[j] = acc[ai][0][m][0][j]; g[4 + j] = acc[ai][0][m][1][j]; uu[j] = acc[ai][1][m][0][j]; uu[4 + j] = acc[ai][1][m][1][j]; }
                e.store_gu(u, row, u.pn * 128 + wc * 32 + 8 * fq, g, uu, rs[ai * 4 + m]); }
    } else if constexpr (E::PF) {
#pragma unroll
        for (int ai = 0; ai < 2; ++ai) {
            U4 pa[8], pb[8]; float pc[8];
#pragma unroll
            for (int q = 0; q < 8; ++q) { const int row = u.pm * 256 + ai * 128 + wr * 64 + (q >> 1) * 16 + fr, col = u.pn * 256 + (q & 1) * 128 + wc * 32 + 8 * fq; e.prefetch(u, row, col, pa[q], pb[q], pc[q]); }
#pragma unroll
            for (int m = 0; m < 4; ++m) { const int row = u.pm * 256 + ai * 128 + wr * 64 + m * 16 + fr; float ss = 0.f;
#pragma unroll
                for (int bj = 0; bj < 2; ++bj) { const int col = u.pn * 256 + bj * 128 + wc * 32 + 8 * fq; float v[8];
#pragma unroll
                    for (int j = 0; j < 4; ++j) { v[j] = acc[ai][bj][m][0][j]; v[4 + j] = acc[ai][bj][m][1][j]; }
                    ss += e.store8p(u, row, col, v, rs[ai * 4 + m], pa[m * 2 + bj], pb[m * 2 + bj], pc[m * 2 + bj]); }
                if constexpr (E::SSQ) { ss += __shfl_xor(ss, 16, 64); ss += __shfl_xor(ss, 32, 64); if (fq == 0) atomicAdd(e.ssq + row, ssq_fix(ss)); } } }
    } else {
#pragma unroll
        for (int ai = 0; ai < 2; ++ai)
#pragma unroll
            for (int m = 0; m < 4; ++m)
            { const int row = u.pm * 256 + ai * 128 + wr * 64 + m * 16 + fr; float ss = 0.f;
#pragma unroll
                for (int bj = 0; bj < 2; ++bj) { const int col = u.pn * 256 + bj * 128 + wc * 32 + 8 * fq; float v[8];
#pragma unroll
                    for (int j = 0; j < 4; ++j) { v[j] = acc[ai][bj][m][0][j]; v[4 + j] = acc[ai][bj][m][1][j]; }
                    if constexpr (E::SSQ) ss += e.store8(u, row, col, v, rs[ai * 4 + m]); else e.store8(u, row, col, v, rs[ai * 4 + m]); }
                if constexpr (E::SSQ) { ss += __shfl_xor(ss, 16, 64); ss += __shfl_xor(ss, 32, 64); if (fq == 0) atomicAdd(e.ssq + row, ssq_fix(ss)); } }
    }
}

template <class Epi, class Sched>
__device__ __forceinline__ void gemm_phase(const Ctx& ctx, const Sched& S, const Epi& E) {
    LAS unsigned char* lds = (LAS unsigned char*)ctx.smem;
    const int tid = ctx.tid, wid = __builtin_amdgcn_readfirstlane(tid >> 6), lane = tid & 63, wr = wid >> 2, wc = wid & 3, fr = lane & 15, fq = lane >> 4;
    int RA[2], RB[2], CC[2];
#pragma unroll
    for (int i = 0; i < 2; ++i) { int R, C; stage_rc(tid * 16 + i * 8192, R, C); RA[i] = R; RB[i] = (R & ~31) + perm32(R & 31); CC[i] = C; }
    const size_t kstep = 128;
    const unsigned ldsw = (unsigned)wid * 1024u;
    const int aoff = lds_byte(wr * 64 + fr, fq * 8), boff = lds_byte(wc * 32 + fr, fq * 8);
#define G_SA(b, h) (((b) * 2 + (h)) * HTB)
#define G_SB(b, h) ((4 + (b) * 2 + (h)) * HTB)
#define G_STAGE(bufoff, gbase, RR, ld) do { _Pragma("unroll") for (int _i = 0; _i < 2; ++_i) \
        __builtin_amdgcn_global_load_lds((const unsigned*)((const char*)(gbase) + (size_t)((unsigned)(RR[_i] * (ld) + CC[_i]) * 2u)), (LAS unsigned*)(lds + (bufoff) + ldsw + _i * 8192), 16, 0, 0); } while (0)
#define G_LDA(dst, b, h) do { _Pragma("unroll") for (int m = 0; m < 4; ++m) _Pragma("unroll") for (int k = 0; k < 2; ++k) dst[m][k] = *(const LAS bf16x8*)(lds + G_SA(b, h) + aoff + m * 2048 + k * 1024); } while (0)
#define G_LDB(dst, b, h) do { _Pragma("unroll") for (int n = 0; n < 2; ++n) _Pragma("unroll") for (int k = 0; k < 2; ++k) dst[n][k] = *(const LAS bf16x8*)(lds + G_SB(b, h) + boff + n * 2048 + k * 1024); } while (0)
#define G_MMA(ai, bj, At, Bt) do { __builtin_amdgcn_s_setprio(1); _Pragma("unroll") for (int m = 0; m < 4; ++m) _Pragma("unroll") for (int n = 0; n < 2; ++n) _Pragma("unroll") for (int k = 0; k < 2; ++k) \
        acc[ai][bj][m][n] = __builtin_amdgcn_mfma_f32_16x16x32_bf16(Bt[n][k], At[m][k], acc[ai][bj][m][n], 0, 0, 0); __builtin_amdgcn_s_setprio(0); } while (0)
#define G_WAIT_V(n) asm volatile("s_waitcnt vmcnt(" #n ")" ::: "memory")
#define G_WAIT_L(n) asm volatile("s_waitcnt lgkmcnt(" #n ")" ::: "memory")
#define G_BAR __builtin_amdgcn_s_barrier()
#define G_SCHED __builtin_amdgcn_sched_barrier(0)
    Unit cur, nxt; int ui = 0;
    if (!S.next(0, cur)) return;
    f32x4 acc[2][2][4][2];
#pragma unroll
    for (int a = 0; a < 2; ++a)
#pragma unroll
        for (int b = 0; b < 2; ++b)
#pragma unroll
            for (int m = 0; m < 4; ++m)
#pragma unroll
                for (int n = 0; n < 2; ++n) acc[a][b][m][n] = (f32x4){0.f, 0.f, 0.f, 0.f};
    bf16x8 At[4][2], B0[2][2], B1[2][2];
    float rs[8] = {0.f, 0.f, 0.f, 0.f, 0.f, 0.f, 0.f, 0.f};
    const char* cA = (const char*)cur.A; const char* cB = (const char*)cur.B; int lda = cur.lda, ldb = cur.ldb, nt = cur.nt;
    {
        const size_t hA = (size_t)128 * lda * 2, hB = (size_t)128 * ldb * 2;
        G_STAGE(G_SB(0, 0), cB, RB, ldb); G_STAGE(G_SA(0, 0), cA, RA, lda); G_STAGE(G_SB(0, 1), cB + hB, RB, ldb); G_STAGE(G_SA(0, 1), cA + hA, RA, lda);
        if (wr == 1) G_BAR;
        G_WAIT_V(4); G_BAR;
        G_STAGE(G_SB(1, 0), cB + kstep, RB, ldb); G_STAGE(G_SA(1, 0), cA + kstep, RA, lda); G_STAGE(G_SB(1, 1), cB + hB + kstep, RB, ldb);
        G_WAIT_V(6); G_BAR;
    }
    for (;;) {
        const bool has_next = S.next(ui + 1, nxt);
        const char* nA = has_next ? (const char*)nxt.A : cA; const char* nB = has_next ? (const char*)nxt.B : cB;
        const int nlda = has_next ? nxt.lda : lda, nldb = has_next ? nxt.ldb : ldb;
        const size_t hA = (size_t)128 * lda * 2;
        for (int t = 0; t < nt; t += 2) {
            const bool last = (t == nt - 2);
            if constexpr (Epi::RV) { if (last) {
#pragma unroll
                for (int q = 0; q < 8; ++q) rs[q] = E.rowval(cur, cur.pm * 256 + (q >> 2) * 128 + wr * 64 + (q & 3) * 16 + fr); } }
            const char* a1 = cA + (size_t)(t + 1) * kstep;
            const char* a2 = last ? nA : cA + (size_t)(t + 2) * kstep; const char* b2 = last ? nB : cB + (size_t)(t + 2) * kstep;
            const int lda2 = last ? nlda : lda, ldb2 = last ? nldb : ldb;
            const size_t hA2 = (size_t)128 * lda2 * 2, hB2 = (size_t)128 * ldb2 * 2;
            const char* a3 = a2 + kstep; const char* b3 = b2 + kstep;
            G_LDB(B0, 0, 0); G_SCHED; G_LDA(At, 0, 0); G_STAGE(G_SA(1, 1), a1 + hA, RA, lda);
            G_WAIT_L(8); G_BAR; G_WAIT_L(0); G_MMA(0, 0, At, B0); G_BAR; G_SCHED;
            G_LDB(B1, 0, 1); G_STAGE(G_SB(0, 0), b2, RB, ldb2);
            G_BAR; G_WAIT_L(0); G_MMA(0, 1, At, B1); G_BAR;
            G_LDA(At, 0, 1); G_STAGE(G_SA(0, 0), a2, RA, lda2);
            G_BAR; G_WAIT_L(0); G_MMA(1, 0, At, B0); G_BAR; G_SCHED;
            G_STAGE(G_SB(0, 1), b2 + hB2, RB, ldb2);
            G_WAIT_V(6); G_BAR; G_MMA(1, 1, At, B1); G_BAR;
            G_LDB(B0, 1, 0); G_SCHED; G_LDA(At, 1, 0); G_STAGE(G_SA(0, 1), a2 + hA2, RA, lda2);
            G_WAIT_L(8); G_BAR; G_WAIT_L(0); G_MMA(0, 0, At, B0); G_BAR; G_SCHED;
            G_LDB(B1, 1, 1); G_STAGE(G_SB(1, 0), b3, RB, ldb2);
            G_BAR; G_WAIT_L(0); G_MMA(0, 1, At, B1); G_BAR;
            G_LDA(At, 1, 1); G_STAGE(G_SA(1, 0), a3, RA, lda2);
            G_BAR; G_WAIT_L(0); G_MMA(1, 0, At, B0); G_BAR; G_SCHED;
            G_STAGE(G_SB(1, 1), b3 + hB2, RB, ldb2);
            G_WAIT_V(6); G_BAR; G_MMA(1, 1, At, B1); G_BAR;
        }
        epi_apply(E, acc, cur, wr, wc, fr, fq, rs);
        if (!has_next) break;
#pragma unroll
        for (int a = 0; a < 2; ++a)
#pragma unroll
            for (int b = 0; b < 2; ++b)
#pragma unroll
                for (int m = 0; m < 4; ++m)
#pragma unroll
                    for (int n = 0; n < 2; ++n) acc[a][b][m][n] = (f32x4){0.f, 0.f, 0.f, 0.f};
        cur = nxt; cA = nA; cB = nB; lda = nlda; ldb = nldb; nt = cur.nt; ++ui;
    }
    G_WAIT_V(0);
    if (wr == 0) G_BAR;
    G_BAR;
}
#else
template <class Epi, class Sched>
inline void gemm_phase(const Ctx& ctx, const Sched& S, const Epi& E) {
    Unit u;
    for (int i = 0; S.next(i, u); ++i) {
        const int K = u.nt * 64;
        for (int r = 0; r < 256; ++r) {
            float arow[4096]; for (int k = 0; k < K; ++k) arow[k] = bf2f(u.A[(size_t)r * u.lda + k]);
            if constexpr (Epi::GU) {
                for (int c0 = 0; c0 < 128; c0 += 8) { float g[8], uu[8];
                    for (int j = 0; j < 8; ++j) { float sg = 0, su = 0; const bf16_t* bg = u.B + (size_t)(c0 + j) * u.ldb; const bf16_t* bu = u.B + (size_t)(128 + c0 + j) * u.ldb;
                        for (int k = 0; k < K; ++k) { sg += arow[k] * bf2f(bg[k]); su += arow[k] * bf2f(bu[k]); } g[j] = sg; uu[j] = su; }
                    E.store_gu(u, u.pm * 256 + r, u.pn * 128 + c0, g, uu, E.rowval(u, u.pm * 256 + r)); }
            } else {
                for (int c0 = 0; c0 < 256; c0 += 8) { float v[8];
                    for (int j = 0; j < 8; ++j) { float s = 0; const bf16_t* b = u.B + (size_t)(c0 + j) * u.ldb; for (int k = 0; k < K; ++k) s += arow[k] * bf2f(b[k]); v[j] = s; }
                    if constexpr (Epi::SSQ) { const float q = E.store8(u, u.pm * 256 + r, u.pn * 256 + c0, v, E.rowval(u, u.pm * 256 + r));
#pragma omp atomic
                        E.ssq[u.pm * 256 + r] += ssq_fix(q); } else E.store8(u, u.pm * 256 + r, u.pn * 256 + c0, v, E.rowval(u, u.pm * 256 + r)); }
            }
        }
    }
}
#endif

template <class F> DEV void mm_nt(const bf16_t* As, int lda, const bf16_t* Bs, int ldb, int M, int N, int K, int causal, const Ctx& ctx, F epi) {
    const int ntn = N / 16, ntiles = (M / 16) * ntn;
#ifndef CPU_EMU
    const int wave = ctx.tid >> 6, lane = ctx.tid & 63, nw = ctx.nthr >> 6, r = lane & 15, q = lane >> 4;
    for (int t = wave; t < ntiles; t += nw) {
        const int tm = t / ntn, tn = t % ntn; const int lim = (tm * 16 + 16 + 31) & ~31;
        if (causal == 1 && tn * 16 >= lim) continue;
        const int kend = (causal == 2 && lim < K) ? lim : K;
        f32x4 acc = {0.f, 0.f, 0.f, 0.f};
        const bf16_t* ap = As + (tm * 16 + r) * lda + q * 8; const bf16_t* bp = Bs + (tn * 16 + r) * ldb + q * 8;
        for (int k0 = 0; k0 < kend; k0 += 32) { const bf16x8 a = *(const bf16x8*)(ap + k0); const bf16x8 b = *(const bf16x8*)(bp + k0); acc = __builtin_amdgcn_mfma_f32_16x16x32_bf16(a, b, acc, 0, 0, 0); }
#pragma unroll
        for (int j = 0; j < 4; ++j) epi(tm * 16 + q * 4 + j, tn * 16 + r, acc[j]);
    }
#else
    for (int t = 0; t < ntiles; ++t) {
        const int tm = t / ntn, tn = t % ntn; const int lim = (tm * 16 + 16 + 31) & ~31;
        if (causal == 1 && tn * 16 >= lim) continue;
        const int kend = (causal == 2 && lim < K) ? lim : K;
        for (int i = 0; i < 16; ++i) for (int j = 0; j < 16; ++j) { float s = 0; for (int k = 0; k < kend; ++k) s += bf2f(As[(tm * 16 + i) * lda + k]) * bf2f(Bs[(tn * 16 + j) * ldb + k]); epi(tm * 16 + i, tn * 16 + j, s); }
    }
#endif
}

DEV void conv_job(const Ctx& ctx, const float* src, int sld, int scol0, int ncols, int Ksrc, bf16_t* dst, int dld, int njpad, int Kdst, const float* scale, int mode) {
    float* tile = (float*)ctx.smem;
    const int tilesJ = njpad / 128, tilesK = Kdst / 64, ntl = tilesJ * tilesK;
    const int ncv = ctx.nblk > 64 ? ctx.nblk - 32 : ctx.nblk;
    if (ctx.bid >= ncv) return;
    for (int tl = ctx.bid; tl < ntl; tl += ncv) {
        const int j0 = (tl % tilesJ) * 128, k0 = (tl / tilesJ) * 64;
        for (int e = ctx.tid; e < 2048; e += ctx.nthr) { const int kk = e >> 5, jj = (e & 31) * 4, k = k0 + kk, j = j0 + jj; F4 v; v.x = v.y = v.z = v.w = 0.f;
            if (mode == 3) { if (k < Ksrc) { float t[4]; for (int u = 0; u < 4; ++u) { const int jq = j + u; t[u] = jq < 24 ? src[(size_t)k * sld + (jq < 16 ? 2048 + jq : 3600 + (jq - 16))] : 0.f; } v.x = t[0]; v.y = t[1]; v.z = t[2]; v.w = t[3]; } }
            else if (j < ncols && k < Ksrc) v = *(const F4*)(src + (size_t)k * sld + scol0 + j);
            if (scale && k < Ksrc) { const float sc = scale[k]; v.x *= sc; v.y *= sc; v.z *= sc; v.w *= sc; }
            float* tp = tile + kk * 129 + jj; tp[0] = v.x; tp[1] = v.y; tp[2] = v.z; tp[3] = v.w; }
        SYNC();
        for (int e = ctx.tid; e < 1024; e += ctx.nthr) { const int jj = e >> 3, kv = (e & 7) * 8, j = j0 + jj; int row = j;
            if (mode == 1) row = (j >> 7) * 256 + (j & 127); else if (mode == 2) row = (j >> 7) * 256 + 128 + (j & 127);
            float o[8];
#pragma unroll
            for (int u = 0; u < 8; ++u) o[u] = tile[(kv + u) * 129 + jj];
            st_bf8(dst + (size_t)row * dld + k0 + kv, o); }
        SYNC();
    }
}

DEV void s5_prep_item(const Ctx& ctx, PRM P, int l, int g, bf16_t* BT1, bf16_t* BT3, float* LAM) {
    float* sm = (float*)ctx.smem;
    float* PwR = sm; float* PwI = PwR + 17 * 64; float* BbR = PwI + 17 * 64; float* BbI = BbR + 1024; float* CR = BbI + 1024; float* CI = CR + 1024; float* Kt = CI + 1024;
    const float* lam_re = P.in[8] + ((size_t)l * 32 + g) * 64; const float* lam_im = P.in[9] + ((size_t)l * 32 + g) * 64;
    const float step = expf(P.in[10][l * 32 + g]);
    const float* b_re = P.in[11] + ((size_t)l * 32 + g) * 1024; const float* b_im = P.in[12] + ((size_t)l * 32 + g) * 1024;
    const float* c_re = P.in[13] + ((size_t)l * 32 + g) * 1024; const float* c_im = P.in[14] + ((size_t)l * 32 + g) * 1024;
    const float* dsk = P.in[15] + (size_t)l * 512 + g * 16;
    for (int e = ctx.tid; e < 17 * 64; e += ctx.nthr) { const int tau = e / 64, p = e % 64; const float lr = fminf(lam_re[p], -1e-4f), li = lam_im[p];
        const float mg = expf(lr * step * tau), an = li * step * tau; PwR[e] = mg * cosf(an); PwI[e] = mg * sinf(an); }
    for (int e = ctx.tid; e < 1024; e += ctx.nthr) { const int p = e / 16; const float lr = fminf(lam_re[p], -1e-4f), li = lam_im[p];
        const float mg = expf(lr * step), ar = mg * cosf(li * step), ai = mg * sinf(li * step), den = lr * lr + li * li, nr = ar - 1.f;
        const float fr = (nr * lr + ai * li) / den, fi = (ai * lr - nr * li) / den; const float br = b_re[e], bi = b_im[e];
        BbR[e] = fr * br - fi * bi; BbI[e] = fr * bi + fi * br; CR[e] = c_re[e]; CI[e] = c_im[e]; }
    SYNC();
    for (int e = ctx.tid; e < 4096; e += ctx.nthr) { const int tau = e >> 8, h = (e >> 4) & 15, h2 = e & 15; float s = 0.f;
        for (int p = 0; p < 64; ++p) { const float cr = CR[h * 64 + p], ci = CI[h * 64 + p], pr = PwR[tau * 64 + p], pi = PwI[tau * 64 + p];
            const float er = cr * pr - ci * pi, ei = cr * pi + ci * pr; s += er * BbR[p * 16 + h2] - ei * BbI[p * 16 + h2]; }
        Kt[e] = s; }
    SYNC();
    bf16_t* b3 = BT3 + (size_t)g * 256 * 384;
    for (int e = ctx.tid; e < 256 * 384; e += ctx.nthr) { const int n = e / 384, k = e % 384, t = n >> 4, h = n & 15; float v = 0.f;
        if (k < 256) { const int j = k >> 4, h2 = k & 15; if (j <= t) { v = Kt[((t - j) << 8) + (h << 4) + h2]; if (j == t && h == h2) v += dsk[h]; } }
        else { const int kk = k - 256, p = kk & 63; const float cr = CR[h * 64 + p], ci = CI[h * 64 + p], pr = PwR[(t + 1) * 64 + p], pi = PwI[(t + 1) * 64 + p];
            v = kk < 64 ? (cr * pr - ci * pi) : -(cr * pi + ci * pr); }
        b3[e] = f2bf(v); }
    bf16_t* b1 = BT1 + (size_t)g * 256 * 256;
    for (int e = ctx.tid; e < 256 * 256; e += ctx.nthr) { const int n = e >> 8, k = e & 255, j = k >> 4, h2 = k & 15; float v = 0.f;
        if (n < 128) { const int p = n & 63; const float pr = PwR[(15 - j) * 64 + p], pi = PwI[(15 - j) * 64 + p], br = BbR[p * 16 + h2], bi = BbI[p * 16 + h2];
            v = n < 64 ? (pr * br - pi * bi) : (pr * bi + pi * br); }
        b1[e] = f2bf(v); }
    for (int p = ctx.tid; p < 64; p += ctx.nthr) { LAM[(g * 64 + p) * 2] = PwR[16 * 64 + p]; LAM[(g * 64 + p) * 2 + 1] = PwI[16 * 64 + p]; }
    SYNC();
}

DEV void phase_pconv(const Ctx& ctx, const float* p, bf16_t* dst);
DEV void phase_conv(const Ctx& ctx, PRM P, int l) {
    unsigned char* ws = P.ws;
    const size_t gu = (size_t)D * DFF;
    conv_job(ctx, P.in[3] + l * gu, DFF, 0, DFF, D, (bf16_t*)(ws + W_GU1), D, DFFP, D, P.in[2] + l * D, 1);
    conv_job(ctx, P.in[4] + l * gu, DFF, 0, DFF, D, (bf16_t*)(ws + W_GU1), D, DFFP, D, P.in[2] + l * D, 2);
    conv_job(ctx, P.in[5] + l * gu, D, 0, D, DFF, (bf16_t*)(ws + W_D1), DFFP, D, DFFP, nullptr, 0);
    conv_job(ctx, P.in[31] + l * gu, DFF, 0, DFF, D, (bf16_t*)(ws + W_GU2), D, DFFP, D, P.in[30] + l * D, 1);
    conv_job(ctx, P.in[32] + l * gu, DFF, 0, DFF, D, (bf16_t*)(ws + W_GU2), D, DFFP, D, P.in[30] + l * D, 2);
    conv_job(ctx, P.in[33] + l * gu, D, 0, D, DFF, (bf16_t*)(ws + W_D2), DFFP, D, DFFP, nullptr, 0);
    const float* win = P.in[7] + (size_t)l * D * IN_TOTAL; const float* mn = P.in[6] + l * D; bf16_t* bin = (bf16_t*)(ws + W_IN);
    conv_job(ctx, win, IN_TOTAL, 0, 2048, D, bin, D, 2048, D, mn, 0);
    conv_job(ctx, win, IN_TOTAL, 2064, 1536, D, bin + (size_t)2048 * D, D, 1536, D, mn, 0);
    conv_job(ctx, win, IN_TOTAL, 0, 0, D, bin + (size_t)3584 * D, D, 256, D, mn, 3);
    conv_job(ctx, win, IN_TOTAL, 3608, 3072, D, (bf16_t*)(ws + W_G), D, 3072, D, mn, 0);
    conv_job(ctx, P.in[16] + (size_t)l * 512 * 512, 512, 0, 512, 512, (bf16_t*)(ws + W_GLU), 512, 512, 512, nullptr, 0);
    for (int k = 0; k < 3; ++k) conv_job(ctx, P.in[26 + k] + (size_t)l * 512 * D, D, 0, D, 512, (bf16_t*)(ws + W_BR) + (size_t)k * 1024 * 512, 512, D, 512, nullptr, 0);
    conv_job(ctx, P.in[29] + (size_t)l * D * D, D, 0, D, D, (bf16_t*)(ws + W_OUT), D, D, D, nullptr, 0);
    conv_job(ctx, P.in[35] + (size_t)l * D * D, D, 0, D, D, (bf16_t*)(ws + W_PG), D, D, D, P.in[34] + l * D, 0);
    conv_job(ctx, P.in[36] + (size_t)l * PLE * D, D, 0, D, PLE, (bf16_t*)(ws + W_PP), PLE, D, PLE, nullptr, 0);
    if (l == 0) { float* q = (float*)(ws + O_SSQ) + T; for (size_t i = (size_t)ctx.bid * ctx.nthr + ctx.tid; i < (size_t)8 * T; i += (size_t)ctx.nblk * ctx.nthr) q[i] = 0.f; }
    phase_pconv(ctx, P.in[1] + (size_t)l * T * PLE, (bf16_t*)(ws + O_PB));
    for (int g = ctx.nblk - 1 - ctx.bid; g < 32; g += ctx.nblk) s5_prep_item(ctx, P, l, g, (bf16_t*)(ws + W_S1), (bf16_t*)(ws + W_S3), (float*)(ws + W_LAM));
}

#ifndef CPU_EMU
__device__ __forceinline__ float wave_sum(float v) {
#pragma unroll
    for (int o = 32; o > 0; o >>= 1) v += __shfl_xor(v, o, 64);
    return v;
}
#endif
DEV void phase_norm(const Ctx& ctx, const float* src, bf16_t* dst, unsigned* ssq, int rows) {
#ifndef CPU_EMU
    const int lane = ctx.tid & 63, gw = ctx.bid * (ctx.nthr >> 6) + (ctx.tid >> 6), nw = ctx.nblk * (ctx.nthr >> 6);
    for (int row = gw; row < rows; row += nw) { const F4* s4 = (const F4*)(src + (size_t)row * D); F4 v[4]; float ss = 0.f;
#pragma unroll
        for (int i = 0; i < 4; ++i) { v[i] = s4[i * 64 + lane]; ss += v[i].x * v[i].x + v[i].y * v[i].y + v[i].z * v[i].z + v[i].w * v[i].w; }
        ss = wave_sum(ss); if (lane == 0) ssq[row] = ssq_fix(ss);
#pragma unroll
        for (int i = 0; i < 4; ++i) { unsigned* d = (unsigned*)(dst + (size_t)row * D + (i * 64 + lane) * 4); d[0] = pack2(v[i].x, v[i].y); d[1] = pack2(v[i].z, v[i].w); } }
#else
    for (int row = ctx.bid; row < rows; row += ctx.nblk) { float ss = 0; for (int i = 0; i < D; ++i) { const float x = src[(size_t)row * D + i]; ss += x * x; dst[(size_t)row * D + i] = f2bf(x); } ssq[row] = ssq_fix(ss); }
#endif
}
DEV void phase_final(const Ctx& ctx, const bf16_t* hb, float* out, const float* w, const unsigned* ssq, int rows) {
    const size_t n8 = (size_t)rows * (D / 8);
    for (size_t i = (size_t)ctx.bid * ctx.nthr + ctx.tid; i < n8; i += (size_t)ctx.nblk * ctx.nthr) { const int row = (int)(i >> 7), c8 = (int)(i & 127) * 8; const float r = rstd_of(ssq_raw(ssq + row));
        float v[8], ww[8], o[8]; ld_bf8(hb + i * 8, v); ld_f8(w + c8, ww); for (int u = 0; u < 8; ++u) o[u] = v[u] * r * ww[u]; st_f8(out + i * 8, o); }
}
DEV void phase_pconv(const Ctx& ctx, const float* p, bf16_t* dst) {
    const size_t n8 = (size_t)T * PLE / 8;
    for (size_t i = (size_t)ctx.bid * ctx.nthr + ctx.tid; i < n8; i += (size_t)ctx.nblk * ctx.nthr) { float v[8]; ld_f8(p + i * 8, v); st_bf8(dst + i * 8, v); }
}
DEV void phase_s5scan(const Ctx& ctx, bf16_t* XS, const float* S5S, const float* LAM) {
    for (int t2 = ctx.tid; t2 < 64; t2 += ctx.nthr)
        for (int idx = ctx.bid * 64 + t2; idx < SEQH * 32 * 64; idx += ctx.nblk * 64) {
            const int p = idx & 63, g = (idx >> 6) & 31, b = idx >> 11; const float ar = LAM[(g * 64 + p) * 2], ai = LAM[(g * 64 + p) * 2 + 1]; float hr = 0.f, hi = 0.f;
            float ar_[16], ai_[16], br_[16], bi_[16];
#define S5_LOAD(R, I, c0) { _Pragma("unroll") for (int u = 0; u < 16; ++u) { const size_t base = (size_t)(b * NCH16 + (c0) + u) * 32 + g; R[u] = S5S[base * 128 + p]; I[u] = S5S[base * 128 + 64 + p]; } }
#define S5_STEP(R, I, c0) { _Pragma("unroll") for (int u = 0; u < 16; ++u) { const size_t base = (size_t)(b * NCH16 + (c0) + u) * 32 + g; XS[base * 384 + 256 + p] = f2bf(hr); XS[base * 384 + 320 + p] = f2bf(hi); \
                const float nr = ar * hr - ai * hi + R[u], ni = ar * hi + ai * hr + I[u]; hr = nr; hi = ni; } }
            S5_LOAD(ar_, ai_, 0);
            for (int c0 = 0; c0 < NCH16; c0 += 32) { S5_LOAD(br_, bi_, c0 + 16); S5_STEP(ar_, ai_, c0); if (c0 + 32 < NCH16) S5_LOAD(ar_, ai_, c0 + 32); S5_STEP(br_, bi_, c0 + 16); }
#undef S5_LOAD
#undef S5_STEP
        }
}

DEV void gla_gates(const Ctx& ctx, PRM P, int l, const float* SMALL, int row0, int h, float*& bc, float*& la, float* glr, float* w2s, float* b2s) {
    const float* w2 = P.in[17] + (size_t)l * 16 * 256; const float* b2 = P.in[18] + (size_t)l * 256;
    for (int e = ctx.tid; e < 1024; e += ctx.nthr) { glr[e] = SMALL[(size_t)(row0 + (e >> 4)) * 32 + (e & 15)]; w2s[e] = w2[(e >> 6) * 256 + h * 64 + (e & 63)]; }
    for (int e = ctx.tid; e < 64; e += ctx.nthr) b2s[e] = b2[h * 64 + e];
    SYNC();
    for (int e = ctx.tid; e < 4096; e += ctx.nthr) { const int i = e >> 6, k = e & 63; float x = b2s[k];
#pragma unroll
        for (int r = 0; r < 16; ++r) x += glr[i * 16 + r] * w2s[r * 64 + k];
        la[e] = logsig(x) * (1.0f / 16.0f); }
    SYNC();
    for (int e = ctx.tid; e < 512; e += ctx.nthr) { const int blk = e >> 6, k = e & 63; float run = 0.f;
#pragma unroll
        for (int u = 0; u < 8; ++u) { run += la[(blk * 8 + u) * 64 + k]; bc[(blk * 8 + u) * 64 + k] = run; } }
    SYNC();
    for (int e = ctx.tid; e < 4096; e += ctx.nthr) { const int i = e >> 6, k = e & 63, blk = i >> 3; float off = 0.f; for (int b2i = 0; b2i < blk; ++b2i) off += bc[(b2i * 8 + 7) * 64 + k]; la[e] = bc[e] + off; }
    SYNC();
    { float* t = bc; bc = la; la = t; }
}
DEV void gla_a_item(const Ctx& ctx, PRM P, int l, int it, const bf16_t* PROJ, const float* SMALL, float* GST, float* GDEC, float* BCG) {
    const int b = it / (NC64 * 4), c = (it >> 2) % NC64, h = it & 3, row0 = b * SEQ + c * 64;
    float* bc = (float*)ctx.smem; float* la = bc + 4096; float* glr = la + 4096; float* w2s = glr + 1024; float* b2s = w2s + 1024;
    bf16_t* vT = (bf16_t*)(b2s + 64); bf16_t* kdT = vT + 128 * 72;
#ifndef CPU_EMU
    const int ek = ctx.tid, jk = ek >> 3, kk0 = (ek & 7) * 8; const U4 kraw = *(const U4*)(PROJ + (size_t)(row0 + jk) * PROJ_LD + PC_K + h * 64 + kk0);
    U4 vraw[2];
#pragma unroll
    for (int q = 0; q < 2; ++q) { const int e = ctx.tid + q * 512; vraw[q] = *(const U4*)(PROJ + (size_t)(row0 + (e >> 4)) * PROJ_LD + PC_V + h * 128 + (e & 15) * 8); }
#endif
    gla_gates(ctx, P, l, SMALL, row0, h, bc, la, glr, w2s, b2s);
    { float* bg = BCG + (size_t)it * 4096; for (int e = ctx.tid; e < 512; e += ctx.nthr) { float t[8]; for (int u = 0; u < 8; ++u) t[u] = bc[e * 8 + u]; st_f8(bg + e * 8, t); } }
#ifndef CPU_EMU
    { float kv[8]; up_bf8(kraw, kv);
#pragma unroll
        for (int u = 0; u < 8; ++u) kdT[(kk0 + u) * 72 + jk] = f2bf(kv[u] * FEXP(bc[63 * 64 + kk0 + u] - bc[jk * 64 + kk0 + u])); }
#else
    for (int e = ctx.tid; e < 512; e += ctx.nthr) { const int j = e >> 3, k0 = (e & 7) * 8; float kv[8]; ld_bf8(PROJ + (size_t)(row0 + j) * PROJ_LD + PC_K + h * 64 + k0, kv);
        for (int u = 0; u < 8; ++u) kdT[(k0 + u) * 72 + j] = f2bf(kv[u] * FEXP(bc[63 * 64 + k0 + u] - bc[j * 64 + k0 + u])); }
#endif
#ifndef CPU_EMU
#pragma unroll
    for (int q = 0; q < 2; ++q) { const int e = ctx.tid + q * 512, j = e >> 4, d0 = (e & 15) * 8; const U4 w = vraw[q];
#else
    for (int e = ctx.tid; e < 1024; e += ctx.nthr) { const int j = e >> 4, d0 = (e & 15) * 8; const U4 w = *(const U4*)(PROJ + (size_t)(row0 + j) * PROJ_LD + PC_V + h * 128 + d0);
#endif
        vT[(d0 + 0) * 72 + j] = (bf16_t)(w.x & 0xffff); vT[(d0 + 1) * 72 + j] = (bf16_t)(w.x >> 16); vT[(d0 + 2) * 72 + j] = (bf16_t)(w.y & 0xffff); vT[(d0 + 3) * 72 + j] = (bf16_t)(w.y >> 16);
        vT[(d0 + 4) * 72 + j] = (bf16_t)(w.z & 0xffff); vT[(d0 + 5) * 72 + j] = (bf16_t)(w.z >> 16); vT[(d0 + 6) * 72 + j] = (bf16_t)(w.w & 0xffff); vT[(d0 + 7) * 72 + j] = (bf16_t)(w.w >> 16); }
    SYNC();
    float* st = GST + ((size_t)(b * 4 + h) * NC64 + c) * 8192;
    mm_nt(vT, 72, kdT, 72, 128, 64, 64, 0, ctx, [&](int i, int j, float v) { st[i * 64 + j] = v; });
    for (int k = ctx.tid; k < 64; k += ctx.nthr) GDEC[((size_t)(b * 4 + h) * NC64 + c) * 64 + k] = FEXP(bc[63 * 64 + k]);
    SYNC();
}
DEV void phase_gla_scan(const Ctx& ctx, float* GST, const float* GDEC) {
    const int total = SEQH * 4 * 8192;
    for (int idx = ctx.bid * ctx.nthr + ctx.tid; idx < total; idx += ctx.nblk * ctx.nthr) {
        const int bh = idx >> 13, e = idx & 8191; float* base = GST + (size_t)bh * NC64 * 8192 + e; const float* dec = GDEC + (size_t)bh * NC64 * 64 + (e & 63); float run = 0.f;
        float la_[8], da_[8], lb_[8], db_[8];
#define GS_LOAD(L, Dv, c0) { _Pragma("unroll") for (int u = 0; u < 8; ++u) { L[u] = base[(size_t)((c0) + u) * 8192]; Dv[u] = dec[((c0) + u) * 64]; } }
#define GS_STEP(L, Dv, c0) { _Pragma("unroll") for (int u = 0; u < 8; ++u) { base[(size_t)((c0) + u) * 8192] = run; run = Dv[u] * run + L[u]; } }
        GS_LOAD(la_, da_, 0);
        for (int c0 = 0; c0 < NC64; c0 += 16) { GS_LOAD(lb_, db_, c0 + 8); GS_STEP(la_, da_, c0); if (c0 + 16 < NC64) GS_LOAD(la_, da_, c0 + 16); GS_STEP(lb_, db_, c0 + 8); }
#undef GS_LOAD
#undef GS_STEP
    }
}
DEV void gla_c_item(const Ctx& ctx, PRM P, int l, int it, bf16_t* PROJ, const float* BCG, const float* GST) {
    const int b = it / (NC64 * 4), c = (it >> 2) % NC64, h = it & 3, row0 = b * SEQ + c * 64;
    float* bc = (float*)ctx.smem; float* la = bc + 4096; float* glr = la + 4096; float* w2s = glr + 1024; float* b2s = w2s + 1024; u64* ssq = (u64*)(b2s + 64);
    bf16_t* As = (bf16_t*)(ssq + 64); bf16_t* ks = As + 64 * 136; bf16_t* Bs = ks + 64 * 72; float* o = la;
    o = (float*)(Bs + 128 * 136);
    const float* st = GST + ((size_t)(b * 4 + h) * NC64 + c) * 8192;
#ifndef CPU_EMU
    U4 graw[2];
    { const int e0 = ctx.tid, i = e0 >> 3, k0 = (e0 & 7) * 8; const size_t r = (size_t)(row0 + i) * PROJ_LD; float bcv[8], qv[8], kv[8], qo[8], ko[8], s0[8], s1[8];
        ld_f8(BCG + (size_t)it * 4096 + e0 * 8, bcv); const U4 qraw = *(const U4*)(PROJ + r + PC_Q + h * 64 + k0); const U4 kraw = *(const U4*)(PROJ + r + PC_K + h * 64 + k0);
        ld_f8(st + e0 * 8, s0); ld_f8(st + (e0 + 512) * 8, s1);
        U4 vraw[2];
#pragma unroll
        for (int q = 0; q < 2; ++q) { const int e = e0 + q * 512; vraw[q] = *(const U4*)(PROJ + (size_t)(row0 + (e >> 4)) * PROJ_LD + PC_V + h * 128 + (e & 15) * 8);
            graw[q] = *(const U4*)(PROJ + (size_t)(row0 + (e >> 4)) * PROJ_LD + PC_GO + h * 128 + (e & 15) * 8); }
        up_bf8(qraw, qv); up_bf8(kraw, kv);
#pragma unroll
        for (int u = 0; u < 8; ++u) { qo[u] = qv[u] * 0.125f * FEXP(bcv[u]); ko[u] = kv[u] * FEXP(-bcv[u]); }
        st_bf8(As + i * 136 + k0, qo); st_bf8(ks + i * 72 + k0, ko);
        st_bf8(Bs + (e0 >> 3) * 136 + (e0 & 7) * 8, s0); st_bf8(Bs + ((e0 + 512) >> 3) * 136 + (e0 & 7) * 8, s1);
#pragma unroll
        for (int q = 0; q < 2; ++q) { const int e = e0 + q * 512, j = e >> 4, d0 = (e & 15) * 8; const U4 w = vraw[q]; bf16_t* bp = Bs + d0 * 136 + 64 + j;
            bp[0] = (bf16_t)(w.x & 0xffff); bp[136] = (bf16_t)(w.x >> 16); bp[2 * 136] = (bf16_t)(w.y & 0xffff); bp[3 * 136] = (bf16_t)(w.y >> 16);
            bp[4 * 136] = (bf16_t)(w.z & 0xffff); bp[5 * 136] = (bf16_t)(w.z >> 16); bp[6 * 136] = (bf16_t)(w.w & 0xffff); bp[7 * 136] = (bf16_t)(w.w >> 16); } }
#else
    { const float* bg = BCG + (size_t)it * 4096; for (int e = ctx.tid; e < 512; e += ctx.nthr) { float t[8]; ld_f8(bg + e * 8, t); for (int u = 0; u < 8; ++u) bc[e * 8 + u] = t[u]; } }
    for (int e = ctx.tid; e < 512; e += ctx.nthr) { const int i = e >> 3, k0 = (e & 7) * 8; const size_t r = (size_t)(row0 + i) * PROJ_LD; float qv[8], kv[8], qo[8], ko[8];
        ld_bf8(PROJ + r + PC_Q + h * 64 + k0, qv); ld_bf8(PROJ + r + PC_K + h * 64 + k0, kv);
        for (int u = 0; u < 8; ++u) { const float bb = bc[i * 64 + k0 + u]; qo[u] = qv[u] * 0.125f * FEXP(bb); ko[u] = kv[u] * FEXP(-bb); }
        st_bf8(As + i * 136 + k0, qo); st_bf8(ks + i * 72 + k0, ko); }
    for (int e = ctx.tid; e < 1024; e += ctx.nthr) { const int dv = e >> 3, k0 = (e & 7) * 8; float sv[8]; ld_f8(st + dv * 64 + k0, sv); st_bf8(Bs + dv * 136 + k0, sv); }
    for (int e = ctx.tid; e < 1024; e += ctx.nthr) { const int j = e >> 4, d0 = (e & 15) * 8; const U4 w = *(const U4*)(PROJ + (size_t)(row0 + j) * PROJ_LD + PC_V + h * 128 + d0);
        bf16_t* bp = Bs + d0 * 136 + 64 + j;
        bp[0] = (bf16_t)(w.x & 0xffff); bp[136] = (bf16_t)(w.x >> 16); bp[2 * 136] = (bf16_t)(w.y & 0xffff); bp[3 * 136] = (bf16_t)(w.y >> 16);
        bp[4 * 136] = (bf16_t)(w.z & 0xffff); bp[5 * 136] = (bf16_t)(w.z >> 16); bp[6 * 136] = (bf16_t)(w.w & 0xffff); bp[7 * 136] = (bf16_t)(w.w >> 16); }
#endif
    for (int i = ctx.tid; i < 64; i += ctx.nthr) ssq[i] = 0;
    SYNC();
    mm_nt(As, 136, ks, 72, 64, 64, 64, 0, ctx, [&](int i, int j, float v) { As[i * 136 + 64 + j] = (j <= i) ? f2bf(v) : (bf16_t)0; });
    SYNC();
    mm_nt(As, 136, Bs, 136, 64, 128, 128, 0, ctx, [&](int i, int j, float v) { o[i * 132 + j] = v; LDS_ADD(&ssq[i], fx24(v * v)); });
    SYNC();
    const float* gn = P.in[19] + (size_t)l * 128;
#ifndef CPU_EMU
#pragma unroll
    for (int q = 0; q < 2; ++q) { const int e = ctx.tid + q * 512, i = e >> 4, d0 = (e & 15) * 8; bf16_t* gp = PROJ + (size_t)(row0 + i) * PROJ_LD + PC_GO + h * 128 + d0; float gv[8], ov[8];
        up_bf8(graw[q], gv);
#else
    for (int e = ctx.tid; e < 1024; e += ctx.nthr) { const int i = e >> 4, d0 = (e & 15) * 8; bf16_t* gp = PROJ + (size_t)(row0 + i) * PROJ_LD + PC_GO + h * 128 + d0; float gv[8], ov[8];
        ld_bf8(gp, gv);
#endif
        const float r = 1.0f / sqrtf(unfx24(ssq[i]) * (1.0f / 128) + EPS);
#pragma unroll
        for (int u = 0; u < 8; ++u) ov[u] = o[i * 132 + d0 + u] * r * gn[d0 + u] * silu(gv[u]);
        st_bf8(gp, ov); }
    SYNC();
}

DEV void phase_ssd_conv(const Ctx& ctx, PRM P, int l, const bf16_t* PROJ, bf16_t* XC) {
    const float* cw = P.in[20] + (size_t)l * 4096; const float* cb = P.in[21] + (size_t)l * 1024;
    const int total = (TH / 8) * 128;
    for (int idx = ctx.bid * ctx.nthr + ctx.tid; idx < total; idx += ctx.nblk * ctx.nthr) {
        const int cg = idx & 127, r0 = (idx >> 7) * 8, ch = cg * 8; float w[4][8], bias[8], win[3][8];
#pragma unroll
        for (int k = 0; k < 4; ++k) ld_f8(cw + k * 1024 + ch, w[k]);
        ld_f8(cb + ch, bias);
        const bool first = (r0 % SEQ) == 0;
#pragma unroll
        for (int k = 0; k < 3; ++k) { if (first) { for (int u = 0; u < 8; ++u) win[k][u] = 0.f; } else ld_bf8(PROJ + (size_t)(r0 - 3 + k) * PROJ_LD + PC_X + ch, win[k]); }
#pragma unroll
        for (int j = 0; j < 8; ++j) { float cur[8], o[8]; ld_bf8(PROJ + (size_t)(r0 + j) * PROJ_LD + PC_X + ch, cur);
#pragma unroll
            for (int u = 0; u < 8; ++u) { o[u] = silu(bias[u] + w[0][u] * win[0][u] + w[1][u] * win[1][u] + w[2][u] * win[2][u] + w[3][u] * cur[u]); win[0][u] = win[1][u]; win[1][u] = win[2][u]; win[2][u] = cur[u]; }
            st_bf8(XC + (size_t)(r0 + j) * 1024 + ch, o); }
    }
}
DEV void ssd_dtcum(const Ctx& ctx, PRM P, int l, const float* SMALL, int row0, int g, float* dt, float* cum, float* la) {
    for (int e = ctx.tid; e < 512; e += ctx.nthr) { const int h4 = e >> 7, i = e & 127, hd = g * 4 + h4; const float d = softplus(SMALL[(size_t)(row0 + i) * 32 + 16 + hd] + P.in[22][l * 8 + hd]);
        dt[e] = d; la[e] = d * -FEXP(P.in[23][l * 8 + hd]); }
    SYNC();
    for (int e = ctx.tid; e < 512; e += ctx.nthr) { const int i = e & 127, base = e - i; float run = 0.f; for (int u = 0; u <= i; ++u) run += la[base + u]; cum[e] = run; }
    SYNC();
}
DEV void ssd_a_item(const Ctx& ctx, PRM P, int l, int it, const bf16_t* XC, const float* SMALL, float* SST, float* SDEC) {
    const int b = it / (NC128 * 2), c = (it >> 1) % NC128, g = it & 1, row0 = b * SEQ + c * 128;
    float* dt = (float*)ctx.smem; float* cum = dt + 512; float* la = cum + 512; bf16_t* BT = (bf16_t*)(la + 512); bf16_t* xdT = BT + 128 * 136;
    ssd_dtcum(ctx, P, l, SMALL, row0, g, dt, cum, la);
    for (int e = ctx.tid; e < 2048; e += ctx.nthr) { const int i = e >> 4, n0 = (e & 15) * 8; const U4 w = *(const U4*)(XC + (size_t)(row0 + i) * 1024 + 512 + g * 128 + n0); bf16_t* bp = BT + n0 * 136 + i;
        bp[0] = (bf16_t)(w.x & 0xffff); bp[136] = (bf16_t)(w.x >> 16); bp[2 * 136] = (bf16_t)(w.y & 0xffff); bp[3 * 136] = (bf16_t)(w.y >> 16);
        bp[4 * 136] = (bf16_t)(w.z & 0xffff); bp[5 * 136] = (bf16_t)(w.z >> 16); bp[6 * 136] = (bf16_t)(w.w & 0xffff); bp[7 * 136] = (bf16_t)(w.w >> 16); }
    for (int e = ctx.tid; e < 4096; e += ctx.nthr) { const int i = e >> 5, q0 = (e & 31) * 8, h4 = q0 >> 6; float xv[8]; ld_bf8(XC + (size_t)(row0 + i) * 1024 + g * 256 + q0, xv);
        const float sc = dt[h4 * 128 + i] * FEXP(cum[h4 * 128 + 127] - cum[h4 * 128 + i]);
#pragma unroll
        for (int u = 0; u < 8; ++u) xdT[(q0 + u) * 136 + i] = f2bf(xv[u] * sc); }
    SYNC();
    float* st = SST + ((size_t)(b * 8 + g * 4) * NC128) * 8192;
    mm_nt(xdT, 136, BT, 136, 256, 128, 128, 0, ctx, [&](int i, int j, float v) { st[((size_t)(i >> 6) * NC128 + c) * 8192 + (i & 63) * 128 + j] = v; });
    for (int h4 = ctx.tid; h4 < 4; h4 += ctx.nthr) SDEC[(size_t)(b * 8 + g * 4 + h4) * NC128 + c] = FEXP(cum[h4 * 128 + 127]);
    SYNC();
}
DEV void phase_ssd_scan(const Ctx& ctx, float* SST, const float* SDEC) {
    const int total = SEQH * 8 * 8192;
    for (int idx = ctx.bid * ctx.nthr + ctx.tid; idx < total; idx += ctx.nblk * ctx.nthr) {
        const int bh = idx >> 13, e = idx & 8191; float* base = SST + (size_t)bh * NC128 * 8192 + e; const float* dec = SDEC + (size_t)bh * NC128; float run = 0.f;
        float la_[8], lb_[8];
#define SS_LOAD(L, c0) { _Pragma("unroll") for (int u = 0; u < 8; ++u) L[u] = base[(size_t)((c0) + u) * 8192]; }
#define SS_STEP(L, c0) { _Pragma("unroll") for (int u = 0; u < 8; ++u) { base[(size_t)((c0) + u) * 8192] = run; run = dec[(c0) + u] * run + L[u]; } }
        SS_LOAD(la_, 0);
        for (int c0 = 0; c0 < NC128; c0 += 16) { SS_LOAD(lb_, c0 + 8); SS_STEP(la_, c0); if (c0 + 16 < NC128) SS_LOAD(la_, c0 + 16); SS_STEP(lb_, c0 + 8); }
#undef SS_LOAD
#undef SS_STEP
    }
}
template <int M, int N, class F> DEV void mm_nt2(const bf16_t* A1, const bf16_t* B1, const float* rowscale, const bf16_t* A2, const bf16_t* B2, int ld, int K, const Ctx& ctx, F epi) {
    constexpr int ntn = N / 16, ntiles = (M / 16) * ntn;
#ifndef CPU_EMU
    const int wave = ctx.tid >> 6, lane = ctx.tid & 63, r = lane & 15, q = lane >> 4;
#pragma unroll
    for (int tt = 0; tt < ntiles / 8; ++tt) {
        const int t = wave + tt * 8, tm = t / ntn, tn = t % ntn; const int lim = (tm * 16 + 16 + 31) & ~31; const int kend = lim < K ? lim : K;
        f32x4 acc = {0.f, 0.f, 0.f, 0.f};
        const bf16_t* ap = A1 + (tm * 16 + r) * ld + q * 8; const bf16_t* bp = B1 + (tn * 16 + r) * ld + q * 8;
        for (int k0 = 0; k0 < K; k0 += 32) acc = __builtin_amdgcn_mfma_f32_16x16x32_bf16(*(const bf16x8*)(ap + k0), *(const bf16x8*)(bp + k0), acc, 0, 0, 0);
#pragma unroll
        for (int j = 0; j < 4; ++j) acc[j] *= rowscale[tm * 16 + q * 4 + j];
        ap = A2 + (tm * 16 + r) * ld + q * 8; bp = B2 + (tn * 16 + r) * ld + q * 8;
        for (int k0 = 0; k0 < kend; k0 += 32) acc = __builtin_amdgcn_mfma_f32_16x16x32_bf16(*(const bf16x8*)(ap + k0), *(const bf16x8*)(bp + k0), acc, 0, 0, 0);
#pragma unroll
        for (int j = 0; j < 4; ++j) epi(tm * 16 + q * 4 + j, tn * 16 + r, acc[j], tt * 4 + j);
    }
#else
    for (int t = 0; t < ntiles; ++t) {
        const int tm = t / ntn, tn = t % ntn; const int lim = (tm * 16 + 16 + 31) & ~31; const int kend = lim < K ? lim : K;
        for (int i = 0; i < 16; ++i) for (int j = 0; j < 16; ++j) { float s = 0; for (int k = 0; k < K; ++k) s += bf2f(A1[(tm * 16 + i) * ld + k]) * bf2f(B1[(tn * 16 + j) * ld + k]);
            s *= rowscale[tm * 16 + i]; for (int k = 0; k < kend; ++k) s += bf2f(A2[(tm * 16 + i) * ld + k]) * bf2f(B2[(tn * 16 + j) * ld + k]); epi(tm * 16 + i, tn * 16 + j, s, -1); }
    }
#endif
}
template <class F> DEV void mm_foreach(int M, int N, const Ctx& ctx, F f) {
    const int ntn = N / 16, ntiles = (M / 16) * ntn;
#ifndef CPU_EMU
    const int wave = ctx.tid >> 6, lane = ctx.tid & 63, nw = ctx.nthr >> 6, r = lane & 15, q = lane >> 4;
    for (int t = wave; t < ntiles; t += nw) { const int tm = t / ntn, tn = t % ntn;
#pragma unroll
        for (int j = 0; j < 4; ++j) f(tm * 16 + q * 4 + j, tn * 16 + r); }
#else
    for (int t = 0; t < ntiles; ++t) { const int tm = t / ntn, tn = t % ntn; for (int i = 0; i < 16; ++i) for (int j = 0; j < 16; ++j) f(tm * 16 + i, tn * 16 + j); }
#endif
}
DEV void ssd_c_item(const Ctx& ctx, PRM P, int l, int it, bf16_t* PROJ, const bf16_t* XC, const float* SMALL, const float* SST) {
    const int b = it / (NC128 * 2), c = (it >> 1) % NC128, g = it & 1, row0 = b * SEQ + c * 128;
    float* dt = (float*)ctx.smem; float* cum = dt + 512; float* la = cum + 512; u64* ssq = (u64*)(la + 512); float* ecum = (float*)(ssq + 128);
    bf16_t* Cs = (bf16_t*)(ecum + 128); bf16_t* Bs = Cs + 128 * 136; bf16_t* Sb = Bs + 128 * 136; bf16_t* xsT = Sb + 128 * 136; bf16_t* hin = xsT + 64 * 136; bf16_t* W = Bs;
    ssd_dtcum(ctx, P, l, SMALL, row0, g, dt, cum, la);
    for (int e = ctx.tid; e < 2048; e += ctx.nthr) { const int i = e >> 4, n0 = (e & 15) * 8; const bf16_t* src = XC + (size_t)(row0 + i) * 1024 + 512 + g * 128 + n0;
        *(U4*)(Bs + i * 136 + n0) = *(const U4*)src; *(U4*)(Cs + i * 136 + n0) = *(const U4*)(src + 256); }
    for (int i = ctx.tid; i < 128; i += ctx.nthr) ssq[i] = 0;
    SYNC();
    mm_nt(Cs, 136, Bs, 136, 128, 128, 128, 1, ctx, [&](int i, int j, float v) { Sb[i * 136 + j] = f2bf(v); });
    SYNC();
#ifndef CPU_EMU
    float yv[4][16];
    const int wave_ = ctx.tid >> 6, lane_ = ctx.tid & 63, r_ = lane_ & 15, q_ = lane_ >> 4;
#endif
#pragma unroll
    for (int h4 = 0; h4 < 4; ++h4) {
        const int hd = g * 4 + h4; const float* cm = cum + h4 * 128; const float* dth = dt + h4 * 128;
#ifndef CPU_EMU
        float zv[16];
#pragma unroll
        for (int tt = 0; tt < 4; ++tt) { const int t = wave_ + tt * 8, tm = t >> 2, tn = t & 3;
#pragma unroll
            for (int j = 0; j < 4; ++j) zv[tt * 4 + j] = bf2f(PROJ[(size_t)(row0 + tm * 16 + q_ * 4 + j) * PROJ_LD + PC_Z + hd * 64 + tn * 16 + r_]); }
#endif
        for (int e = ctx.tid; e < 2048; e += ctx.nthr) { const int i = e >> 4, m0 = (e & 15) * 8; const int lim = ((i & ~15) + 16 + 31) & ~31;
            if (m0 < lim) { float sv[8], wv[8]; ld_bf8(Sb + i * 136 + m0, sv); const float ci = cm[i];
#pragma unroll
                for (int u = 0; u < 8; ++u) { const int m = m0 + u; wv[u] = (m <= i) ? sv[u] * FEXP(ci - cm[m]) * dth[m] : 0.f; }
                st_bf8(W + i * 136 + m0, wv); } }
        for (int e = ctx.tid; e < 1024; e += ctx.nthr) { const int i = e >> 3, p0 = (e & 7) * 8; const U4 w = *(const U4*)(XC + (size_t)(row0 + i) * 1024 + hd * 64 + p0); bf16_t* bp = xsT + p0 * 136 + i;
            bp[0] = (bf16_t)(w.x & 0xffff); bp[136] = (bf16_t)(w.x >> 16); bp[2 * 136] = (bf16_t)(w.y & 0xffff); bp[3 * 136] = (bf16_t)(w.y >> 16);
            bp[4 * 136] = (bf16_t)(w.z & 0xffff); bp[5 * 136] = (bf16_t)(w.z >> 16); bp[6 * 136] = (bf16_t)(w.w & 0xffff); bp[7 * 136] = (bf16_t)(w.w >> 16); }
        const float* st = SST + ((size_t)(b * 8 + hd) * NC128 + c) * 8192;
        for (int e = ctx.tid; e < 1024; e += ctx.nthr) { const int p = e >> 4, n0 = (e & 15) * 8; float sv[8]; ld_f8(st + p * 128 + n0, sv); st_bf8(hin + p * 136 + n0, sv); }
        for (int i = ctx.tid; i < 128; i += ctx.nthr) ecum[i] = FEXP(cm[i]);
        SYNC();
        const float dsk = P.in[24][l * 8 + hd];
        mm_nt2<128, 64>(Cs, hin, ecum, W, xsT, 136, 128, ctx, [&](int i, int j, float v, int slot) {
#ifndef CPU_EMU
            const float y = bf2f(f2bf((v + dsk * bf2f(xsT[j * 136 + i])) * silu(zv[slot]))); yv[h4][slot] = y; LDS_ADD(&ssq[i], fx24(y * y));
#else
            bf16_t* zp = PROJ + (size_t)(row0 + i) * PROJ_LD + PC_Z + hd * 64 + j; const bf16_t yb = f2bf((v + dsk * bf2f(xsT[j * 136 + i])) * silu(bf2f(*zp)));
            *zp = yb; const float y = bf2f(yb); LDS_ADD(&ssq[i], fx24(y * y)); (void)slot;
#endif
        });
        SYNC();
    }
    const float* nw = P.in[25] + (size_t)l * 512 + g * 256;
#ifndef CPU_EMU
#pragma unroll
    for (int h4 = 0; h4 < 4; ++h4)
#pragma unroll
        for (int tt = 0; tt < 4; ++tt) { const int t = wave_ + tt * 8, tm = t >> 2, tn = t & 3;
#pragma unroll
            for (int j = 0; j < 4; ++j) { const int i = tm * 16 + q_ * 4 + j, col = h4 * 64 + tn * 16 + r_;
                PROJ[(size_t)(row0 + i) * PROJ_LD + PC_Z + g * 256 + col] = f2bf(yv[h4][tt * 4 + j] * (1.0f / sqrtf(unfx24(ssq[i]) * (1.0f / 256) + EPS)) * nw[col]); } }
#else
    for (int h4 = 0; h4 < 4; ++h4)
        mm_foreach(128, 64, ctx, [&](int i, int j) { bf16_t* zp = PROJ + (size_t)(row0 + i) * PROJ_LD + PC_Z + (g * 4 + h4) * 64 + j;
            *zp = f2bf(bf2f(*zp) * (1.0f / sqrtf(unfx24(ssq[i]) * (1.0f / 256) + EPS)) * nw[h4 * 64 + j]); });
#endif
    SYNC();
}

constexpr int PH_L0 = 19, PH_L1 = 19, PH_TOTAL = PH_L0 + PH_L1 + 1;
DEV void run_phase(const Ctx& ctx, PRM P, int ph) {
    unsigned char* ws = P.ws; unsigned* SSQ = (unsigned*)(ws + O_SSQ); unsigned char* osc = (unsigned char*)P.out;
    if (ph < 0) return;
    if (ph == PH_TOTAL - 1) { phase_final(ctx, (bf16_t*)(ws + O_HB), P.out, P.in[37], SSQ + (size_t)8 * T, T); return; }
    int l = 0, s = ph; if (ph >= PH_L0) { l = 1; s = ph - PH_L0; } if (s >= 1) s += 1;
    bf16_t* HB = (bf16_t*)(ws + (l == 0 ? O_HB : O_HB2)); bf16_t* HBN = (bf16_t*)(ws + (l == 0 ? O_HB2 : O_HB));
    unsigned* ssq1 = SSQ + (size_t)(l * 4 + 0) * T; unsigned* ssq2 = ssq1 + T; unsigned* ssq3 = ssq2 + T; unsigned* ssq4 = ssq3 + T; unsigned* ssq5 = ssq4 + T;
    if (s == 0) { phase_conv(ctx, P, l); if (l == 0) phase_norm(ctx, P.in[0], HB, ssq1, T); return; }
    if (s == 1) return;
    if (s == 2 || s == 17) { SchedSimple S; S.init(HB, D, (bf16_t*)(ws + (s == 2 ? W_GU1 : W_GU2)), D, T, NGU, D, ctx.nblk, ctx.bid); EpiSwiglu E{(bf16_t*)(ws + O_ACT), s == 2 ? ssq1 : ssq3}; gemm_phase(ctx, S, E); return; }
    if (s == 3 || s == 18) { SchedSimple S; S.init((bf16_t*)(ws + O_ACT), DFFP, (bf16_t*)(ws + (s == 3 ? W_D1 : W_D2)), DFFP, T, D, DFFP, ctx.nblk, ctx.bid); EpiResid E{HB, HB, 0.5f, s == 3 ? ssq2 : ssq4}; gemm_phase(ctx, S, E); return; }
    if (s == 19) { SchedPle S{(bf16_t*)(ws + O_PB), (bf16_t*)(ws + W_PP), HB, (bf16_t*)(ws + W_PG), (T / 256) * 4, ctx.nblk, ctx.bid}; EpiPle E{HB, (bf16_t*)(ws + O_PP), HBN, ssq4, ssq5}; gemm_phase(ctx, S, E); return; }
    const int half = s <= 10 ? 0 : 1, lv = s <= 10 ? s - 4 : s - 10;
    bf16_t* HBh = HB + (size_t)half * TH * D;
    bf16_t* PROJ = (bf16_t*)(ws + O_PROJ); float* SMALL = (float*)(ws + O_SMALL); bf16_t* XS = (bf16_t*)(ws + O_XS); float* S5S = (float*)(ws + O_S5S);
    bf16_t* GS5 = (bf16_t*)(osc + OUT_GS5); bf16_t* YS5 = (bf16_t*)(osc + OUT_YS5); bf16_t* GATES = (bf16_t*)(osc + OUT_GATES); float* GST = (float*)(ws + O_GST); float* GDEC = (float*)(ws + O_GDEC);
    float* SST = (float*)(ws + O_SST); float* SDEC = (float*)(ws + O_SDEC); bf16_t* SG = (bf16_t*)(ws + O_SG); bf16_t* MG = (bf16_t*)(ws + O_MG);
    if (lv == 0) { SchedSimple S; S.init(HBh, D, (bf16_t*)(ws + W_IN), D, TH, IN_N + 3072, D, ctx.nblk, ctx.bid); EpiWin E{XS, PROJ, SMALL, GATES, ssq2 + (size_t)half * TH}; gemm_phase(ctx, S, E); return; }
    bf16_t* XC = (bf16_t*)(ws + O_SG);
    if (lv == 1) {
        { SchedS5 S{XS, (bf16_t*)(ws + W_S1), 256, CHH / 256, ctx.nblk, ctx.bid}; EpiS5P1 E{S5S}; gemm_phase(ctx, S, E); }
        phase_ssd_conv(ctx, P, l, PROJ, XC);
        for (int it = ctx.bid; it < SEQH * NC64 * 4; it += ctx.nblk) gla_a_item(ctx, P, l, it, PROJ, SMALL, GST, GDEC, (float*)(ws + O_BCG));
        return; }
    if (lv == 2) { for (int it = ctx.bid; it < SEQH * NC128 * 2; it += ctx.nblk) ssd_a_item(ctx, P, l, it, XC, SMALL, SST, SDEC);
        phase_s5scan(ctx, XS, S5S, (const float*)(ws + W_LAM)); phase_gla_scan(ctx, GST, GDEC); return; }
    if (lv == 3) {
        { SchedS5 S{XS, (bf16_t*)(ws + W_S3), 384, CHH / 256, ctx.nblk, ctx.bid}; EpiS5P3 E{GS5}; gemm_phase(ctx, S, E); }
        phase_ssd_scan(ctx, SST, SDEC);
        for (int it = ctx.bid; it < SEQH * NC64 * 4; it += ctx.nblk) gla_c_item(ctx, P, l, it, PROJ, (const float*)(ws + O_BCG), GST);
        return; }
    if (lv == 4) { { SchedSimple S; S.init(GS5, 512, (bf16_t*)(ws + W_GLU), 512, TH, 512, 512, ctx.nblk, ctx.bid); EpiGlu E{GS5, YS5}; gemm_phase(ctx, S, E); }
        for (int it = ctx.bid; it < SEQH * NC128 * 2; it += ctx.nblk) ssd_c_item(ctx, P, l, it, PROJ, XC, SMALL, SST); return; }
    if (lv == 5) { SchedMerge S{(bf16_t*)(ws + W_BR), YS5, PROJ, (TH / 256) * 4, ctx.nblk, ctx.bid}; EpiMerge E{GATES, MG}; gemm_phase(ctx, S, E); return; }
    if (lv == 6) { { SchedSimple S; S.init(MG, D, (bf16_t*)(ws + W_OUT), D, TH, D, D, ctx.nblk, ctx.bid); EpiResid E{HBh, HBh, 1.0f, ssq3 + (size_t)half * TH}; gemm_phase(ctx, S, E); }
        if (half == 0) { bf16_t* HB1 = HB + (size_t)TH * D;
            SchedSimple S; S.init(HB1, D, (bf16_t*)(ws + W_IN), D, TH, IN_N + 3072, D, ctx.nblk, ctx.bid); EpiWin E{XS, PROJ, SMALL, GATES, ssq2 + (size_t)TH}; gemm_phase(ctx, S, E); }
        return; }
}

#ifndef CPU_EMU
#define XB_TMO      128
#define XB_XCNT(j)  (256  + 64 * (j))
#define XB_XSUB(j)  (1280 + 64 * (j))
#define XB_XGEN(j)  (2304 + 64 * (j))
#define XB_TOP      3328
#define XB_TOPGEN   3392
#define XCD_BAR_WORDS 3456
#define XB_SPIN_CAP (1u << 18)
__device__ __forceinline__ unsigned xb_ld(unsigned* p)              { return __hip_atomic_load(p, __ATOMIC_RELAXED, __HIP_MEMORY_SCOPE_AGENT); }
__device__ __forceinline__ unsigned xb_add(unsigned* p, unsigned v) { return __hip_atomic_fetch_add(p, v, __ATOMIC_RELAXED, __HIP_MEMORY_SCOPE_AGENT); }
__device__ __forceinline__ unsigned xb_xcc_id() { return (unsigned)__builtin_amdgcn_s_getreg((3 << 11) | 20) & 0xFu; }
#define XB_SPIN(cond, bar) do { unsigned _sp = 0; while (cond) { __builtin_amdgcn_s_sleep(1); \
    if ((++_sp & 255u) == 0u) { if (xb_ld(&(bar)[XB_TMO])) break; if (_sp > XB_SPIN_CAP) { atomicAdd(&(bar)[XB_TMO], 1u); break; } } } } while (0)
struct XcdBarrier { unsigned* bar; unsigned x; volatile LAS unsigned* st; };
__device__ __forceinline__ XcdBarrier xcd_barrier_post(unsigned* bar, volatile LAS unsigned* st) {
    XcdBarrier b; b.bar = bar; b.x = xb_xcc_id(); b.st = st;
    if (threadIdx.x == 0) (void)xb_add(&bar[XB_XCNT(b.x)], 1u);
    return b;
}
__device__ __forceinline__ void xcd_barrier_complete(unsigned* bar, unsigned x, unsigned& nloc, unsigned& nx) {
    const unsigned G = gridDim.x * gridDim.y * gridDim.z;
    unsigned sum, cnt, mine, sp = 0u;
    for (;;) {
        sum = 0u; cnt = 0u; mine = 0u;
#pragma unroll
        for (unsigned j = 0; j < 16; ++j) { const unsigned c = xb_ld(&bar[XB_XCNT(j)]); sum += c; cnt += (c > 0u) ? 1u : 0u; mine = (j == x) ? c : mine; }
        if (sum == G) break;
        __builtin_amdgcn_s_sleep(1);
        if ((++sp & 255u) == 0u) { if (xb_ld(&bar[XB_TMO])) break; if (sp > XB_SPIN_CAP) { atomicAdd(&bar[XB_TMO], 1u); break; } }
    }
    nloc = mine > 0u ? mine : 1u; nx = cnt > 0u ? cnt : 1u;
}
__device__ __forceinline__ void xcd_barrier(const XcdBarrier& b) {
    asm volatile("s_waitcnt vmcnt(0)" ::: "memory");
    __syncthreads();
    if (threadIdx.x == 0) {
        unsigned* bar = b.bar;
        __builtin_amdgcn_s_waitcnt(0);
        unsigned nloc = b.st[0], nx = b.st[1];
        if (nloc == 0u) { xcd_barrier_complete(bar, b.x, nloc, nx); b.st[0] = nloc; b.st[1] = nx; }
        const unsigned old = xb_add(&bar[XB_XSUB(b.x)], 1u);
        const unsigned gen = old / nloc;
        if (old + 1u == (gen + 1u) * nloc) {
            __builtin_amdgcn_fence(__ATOMIC_RELEASE, "agent");
            asm volatile("s_waitcnt vmcnt(0)" ::: "memory");
            const unsigned og = xb_add(&bar[XB_TOP], 1u);
            const unsigned tg = og / nx;
            if (og + 1u == (tg + 1u) * nx) xb_add(&bar[XB_TOPGEN], 1u);
            else XB_SPIN(xb_ld(&bar[XB_TOPGEN]) == tg, bar);
            __builtin_amdgcn_fence(__ATOMIC_ACQUIRE, "agent");
            xb_add(&bar[XB_XGEN(b.x)], 1u);
            asm volatile("s_waitcnt vmcnt(0)" ::: "memory");
        } else {
            XB_SPIN(xb_ld(&bar[XB_XGEN(b.x)]) == gen, bar);
            __builtin_amdgcn_fence(__ATOMIC_ACQUIRE, "agent");
            asm volatile("s_waitcnt vmcnt(0)" ::: "memory");
        }
    }
    __syncthreads();
}

__global__ void __launch_bounds__(512) hybrid_megakernel(Params P) {
        extern __shared__ __attribute__((aligned(16))) unsigned char smem[];
    volatile LAS unsigned* xst = (volatile LAS unsigned*)(smem + LDS_BYTES);
    if (threadIdx.x == 0) { xst[0] = 0u; xst[1] = 0u; xst[2] = 0u; xst[3] = 0u; }
    __syncthreads();
    (void)xcd_barrier_post((unsigned*)(P.ws + O_BAR), xst);
#define GRID_SYNC(first) do { if (first) cg::this_grid().sync(); else { XcdBarrier xb_; xb_.bar = (unsigned*)(Pp->ws + O_BAR); xb_.x = xb_xcc_id(); xb_.st = (volatile LAS unsigned*)(smem + LDS_BYTES); xcd_barrier(xb_); } } while (0)
#define STEP(n) { const __attribute__((address_space(4))) Params* Pp = (const __attribute__((address_space(4))) Params*)__builtin_amdgcn_kernarg_segment_ptr(); \
        int tid = threadIdx.x, bid = blockIdx.x, nblk = gridDim.x, smo = 0; \
        asm volatile("" : "+s"(Pp), "+v"(tid), "+s"(bid), "+s"(nblk), "+s"(smo)); \
        Ctx ctx; ctx.bid = bid; ctx.nblk = nblk; ctx.tid = tid; ctx.nthr = 512; ctx.smem = smem + smo; \
        run_phase(ctx, *Pp, (n)); \
        if ((n) + 1 < PH_TOTAL + REP_N) GRID_SYNC((n) == 0); }
#ifndef REP_N
#define REP_N 0
#define REP_PH 0
#endif
    STEP(0) STEP(1) STEP(2) STEP(3) STEP(4) STEP(5) STEP(6) STEP(7) STEP(8) STEP(9) STEP(10) STEP(11) STEP(12) STEP(13) STEP(14) STEP(15) STEP(16) STEP(17) STEP(18) STEP(19) STEP(20)
    STEP(21) STEP(22) STEP(23) STEP(24) STEP(25) STEP(26) STEP(27) STEP(28) STEP(29) STEP(30) STEP(31) STEP(32) STEP(33) STEP(34) STEP(35) STEP(36) STEP(37) STEP(38)
    static_assert(PH_TOTAL == 39, "update the unrolled phase list");
#if REP_N > 0
    for (int r = 0; r < REP_N; ++r) { const __attribute__((address_space(4))) Params* Pp = (const __attribute__((address_space(4))) Params*)__builtin_amdgcn_kernarg_segment_ptr();
        int tid = threadIdx.x, bid = blockIdx.x, nblk = gridDim.x, smo = 0;
        asm volatile("" : "+s"(Pp), "+v"(tid), "+s"(bid), "+s"(nblk), "+s"(smo));
        Ctx ctx; ctx.bid = bid; ctx.nblk = nblk; ctx.tid = tid; ctx.nthr = 512; ctx.smem = smem + smo;
        run_phase(ctx, *Pp, REP_PH);
        if (r + 1 < REP_N) GRID_SYNC(false); }
#endif
}
#endif

#ifndef CPU_EMU
extern "C" void kernel_launch(void* const* d_in, const int* in_sizes, int n_in, void* d_out, int out_size, void* d_ws, size_t ws_size, hipStream_t stream) {
    static int grid_blocks = 0;
    if (grid_blocks == 0) {
        if (n_in != 38 || ws_size < WS_NEED) { fprintf(stderr, "kernel_launch: need 38 inputs and %zu bytes of workspace (got %d, %zu)\n", (size_t)WS_NEED, n_in, ws_size); grid_blocks = -1; return; }
        int dev = 0, cus = 0, per_cu = 0;
        hipGetDevice(&dev);
        hipDeviceGetAttribute(&cus, hipDeviceAttributeMultiprocessorCount, dev);
        hipFuncSetAttribute((const void*)hybrid_megakernel, hipFuncAttributeMaxDynamicSharedMemorySize, LDS_TOTAL);
        hipOccupancyMaxActiveBlocksPerMultiprocessor(&per_cu, (const void*)hybrid_megakernel, 512, LDS_TOTAL);
        if (per_cu < 1) per_cu = 1;
        grid_blocks = cus * 1;
        (void)hipGetLastError();
    }
    if (grid_blocks < 0) return;
    Params P{};
    for (int i = 0; i < 38; ++i) P.in[i] = (const float*)d_in[i];
    P.out = (float*)d_out; P.ws = (unsigned char*)d_ws;
    (void)hipMemsetAsync((unsigned char*)d_ws + O_BAR, 0, 16384, stream);
    void* args[] = {&P};
    hipError_t e = hipLaunchCooperativeKernel((const void*)hybrid_megakernel, dim3(grid_blocks), dim3(512), args, LDS_TOTAL, stream);
    if (e != hipSuccess) fprintf(stderr, "cooperative launch failed: %s (grid %d)\n", hipGetErrorString(e), grid_blocks);
}
#endif
```

```cpp
#ifndef CPU_EMU
#include <hip/hip_runtime.h>
#include <hip/hip_cooperative_groups.h>
namespace cg = cooperative_groups;
#define DEV __device__ __forceinline__
#define SYNC() __syncthreads()
#else
#include <cmath>
#include <cstring>
#include <cstdio>
#include <cstdlib>
#define DEV inline
#define SYNC() do {} while (0)
#endif

typedef unsigned short bf16_t;

#ifndef EMU_BATCH
#define EMU_BATCH 8
#define EMU_SEQ 4096
#endif
constexpr int BATCH = EMU_BATCH, SEQ = EMU_SEQ, DEPTH = 2;
constexpr int D = 1024, DFF = 2752, DFFP = 2816, NGU = 5632, PLE = 256;
constexpr int T = BATCH * SEQ, TH = T / 2, SEQH = BATCH / 2;
constexpr int NC64 = SEQ / 64, NC128 = SEQ / 128, NCH16 = SEQ / 16, CHH = TH / 16;
constexpr int PROJ_LD = 3072, IN_N = 3840, IN_TOTAL = 6680;
constexpr int PC_Q = 0, PC_K = 256, PC_V = 512, PC_GO = 1024, PC_Z = 1536, PC_X = 2048;
constexpr float EPS = 1e-6f;

constexpr size_t al256(size_t x) { return (x + 255) & ~(size_t)255; }
constexpr size_t SZ_GU = (size_t)NGU * D * 2, SZ_DN = (size_t)D * DFFP * 2;
constexpr size_t W_GU1 = 0, W_D1 = W_GU1 + SZ_GU, W_GU2 = W_D1 + SZ_DN, W_D2 = W_GU2 + SZ_GU;
constexpr size_t W_IN = W_D2 + SZ_DN, W_G = W_IN + (size_t)IN_N * D * 2, W_GLU = W_G + (size_t)3072 * D * 2;
constexpr size_t W_BR = W_GLU + (size_t)512 * 512 * 2, W_OUT = W_BR + (size_t)3 * 1024 * 512 * 2, W_PG = W_OUT + (size_t)D * D * 2;
constexpr size_t W_PP = W_PG + (size_t)D * D * 2, W_S1 = W_PP + (size_t)D * PLE * 2, W_S3 = W_S1 + (size_t)32 * 256 * 256 * 2;
constexpr size_t W_LAM = W_S3 + (size_t)32 * 256 * 384 * 2, W_END = al256(W_LAM + 32 * 64 * 2 * 4);
constexpr size_t O_HB = W_END, O_HB2 = O_HB + (size_t)T * D * 2, O_SSQ = O_HB2 + (size_t)T * D * 2, O_PB = O_SSQ + (size_t)9 * T * 4, O_BIG = O_PB + (size_t)T * PLE * 2;
constexpr size_t O_ACT = O_BIG;
constexpr size_t O_PP = O_BIG;
constexpr size_t O_PROJ = O_BIG, O_SMALL = O_PROJ + (size_t)TH * PROJ_LD * 2, O_XS = O_SMALL + (size_t)TH * 32 * 4;
constexpr size_t O_S5S = O_XS + (size_t)CHH * 32 * 384 * 2, O_GST = O_S5S + (size_t)CHH * 32 * 128 * 4,
    OUT_GATES = 0, OUT_GS5 = (size_t)TH * 3072 * 2, OUT_YS5 = OUT_GS5 + (size_t)TH * 512 * 2;
constexpr size_t O_GDEC = O_GST + (size_t)SEQH * 4 * NC64 * 8192 * 4;
constexpr size_t O_SST = al256(O_GDEC + (size_t)SEQH * 4 * NC64 * 64 * 4), O_SDEC = O_SST + (size_t)SEQH * 8 * NC128 * 8192 * 4;
constexpr size_t O_BCG = al256(O_SDEC + (size_t)SEQH * 8 * NC128 * 4), O_SG = O_BCG + (size_t)SEQH * 4 * NC64 * 4096 * 4, O_MG = O_SG + (size_t)TH * D * 2, O_MIXEND = O_MG + (size_t)TH * D * 2;
constexpr size_t O_FFNEND = O_ACT + (size_t)T * DFFP * 2, O_PLEEND = O_PP + (size_t)T * D * 2;
constexpr size_t WS_NEED0 = (O_MIXEND > O_FFNEND ? (O_MIXEND > O_PLEEND ? O_MIXEND : O_PLEEND) : (O_FFNEND > O_PLEEND ? O_FFNEND : O_PLEEND));
constexpr size_t O_BAR = al256(WS_NEED0), WS_NEED = O_BAR + 16384;
constexpr int LDS_BYTES = 144 * 1024, LDS_TOTAL = LDS_BYTES + 16;

struct Params {
    const float* in[38];
    float* out;
    unsigned char* ws;
};
struct Ctx { int bid, nblk, tid, nthr; unsigned char* smem; };
#ifndef CPU_EMU
#define PRM const __attribute__((address_space(4))) Params&
#else
#define PRM const Params&
#endif

union FU { float f; unsigned u; };
DEV float bf2f(bf16_t b) { FU x; x.u = ((unsigned)b) << 16; return x.f; }
DEV bf16_t f2bf(float f) { FU x; x.f = f; unsigned u = x.u; u += 0x7FFFu + ((u >> 16) & 1u); return (bf16_t)(u >> 16); }
DEV unsigned pack2(float lo, float hi) { return (unsigned)f2bf(lo) | ((unsigned)f2bf(hi) << 16); }
#ifndef CPU_EMU
#define FEXP(x) __expf(x)
#define FLOG(x) __logf(x)
#define FRCP(x) __frcp_rn(x)
#define LDS_ADD(p, v) atomicAdd((p), (v))
#else
#define FEXP(x) expf(x)
#define FLOG(x) logf(x)
#define FRCP(x) (1.0f / (x))
#define LDS_ADD(p, v) (*(p) += (v))
#endif
typedef unsigned long long u64;
DEV u64 fx24(float v) { return (u64)(v * 16777216.0f + 0.5f); }
DEV float unfx24(u64 v) { return (float)v * (1.0f / 16777216.0f); }
DEV float sigm(float x) { return FRCP(1.f + FEXP(-x)); }
DEV float silu(float x) { return x * FRCP(1.f + FEXP(-x)); }
DEV float softplus(float x) { return x > 20.f ? x : FLOG(1.f + FEXP(x)); }
DEV float logsig(float x) { return fminf(x, 0.f) - FLOG(1.f + FEXP(-fabsf(x))); }
DEV float gelu_t(float x) { const float u = 0.7978845608f * (x + 0.044715f * x * x * x); return x * FRCP(1.f + FEXP(-2.f * u)); }
struct alignas(16) U4 { unsigned x, y, z, w; };
struct alignas(16) F4 { float x, y, z, w; };
DEV void st_bf8(bf16_t* p, const float* v) { U4 w; w.x = pack2(v[0], v[1]); w.y = pack2(v[2], v[3]); w.z = pack2(v[4], v[5]); w.w = pack2(v[6], v[7]); *(U4*)p = w; }
DEV void ld_bf8(const bf16_t* p, float* v) { U4 w = *(const U4*)p; v[0] = bf2f((bf16_t)(w.x & 0xffff)); v[1] = bf2f((bf16_t)(w.x >> 16)); v[2] = bf2f((bf16_t)(w.y & 0xffff)); v[3] = bf2f((bf16_t)(w.y >> 16));
    v[4] = bf2f((bf16_t)(w.z & 0xffff)); v[5] = bf2f((bf16_t)(w.z >> 16)); v[6] = bf2f((bf16_t)(w.w & 0xffff)); v[7] = bf2f((bf16_t)(w.w >> 16)); }
DEV void up_bf8(U4 w, float* v) { v[0] = bf2f((bf16_t)(w.x & 0xffff)); v[1] = bf2f((bf16_t)(w.x >> 16)); v[2] = bf2f((bf16_t)(w.y & 0xffff)); v[3] = bf2f((bf16_t)(w.y >> 16));
    v[4] = bf2f((bf16_t)(w.z & 0xffff)); v[5] = bf2f((bf16_t)(w.z >> 16)); v[6] = bf2f((bf16_t)(w.w & 0xffff)); v[7] = bf2f((bf16_t)(w.w >> 16)); }
DEV void st_f8(float* p, const float* v) { F4 a, b; a.x = v[0]; a.y = v[1]; a.z = v[2]; a.w = v[3]; b.x = v[4]; b.y = v[5]; b.z = v[6]; b.w = v[7]; *(F4*)p = a; *(F4*)(p + 4) = b; }
DEV void ld_f8(const float* p, float* v) { F4 a = *(const F4*)p, b = *(const F4*)(p + 4); v[0] = a.x; v[1] = a.y; v[2] = a.z; v[3] = a.w; v[4] = b.x; v[5] = b.y; v[6] = b.z; v[7] = b.w; }

struct Unit { const bf16_t* A; const bf16_t* B; int lda, ldb, nt, pm, pn, sub; };

struct SchedSimple {
    const bf16_t* A; const bf16_t* Bt; int lda, ldb, K, nM, nN, nwg, G, c;
    DEV void init(const bf16_t* A_, int lda_, const bf16_t* Bt_, int ldb_, int M, int N, int K_, int G_, int c_) { A = A_; Bt = Bt_; lda = lda_; ldb = ldb_; K = K_; nM = M / 256; nN = N / 256; nwg = nM * nN; G = G_; c = c_; }
    DEV bool next(int i, Unit& u) const {
        const long L = (long)i * G + c; if (L >= nwg) return false;
        int wgid = (int)L; { const int q = nwg / 8, r = nwg % 8, xcd = wgid % 8, off = wgid / 8; wgid = (xcd < r ? xcd * (q + 1) : r * (q + 1) + (xcd - r) * q) + off; }
        const int nig = 8 * nN, gid = wgid / nig, fm = gid * 8, gsz = (nM - fm) < 8 ? (nM - fm) : 8;
        u.pm = fm + ((wgid % nig) % gsz); u.pn = (wgid % nig) / gsz; u.sub = 0;
        u.A = A + (size_t)u.pm * 256 * lda; u.B = Bt + (size_t)u.pn * 256 * ldb; u.lda = lda; u.ldb = ldb; u.nt = K / 64; return true;
    }
};
struct SchedS5 {
    const bf16_t* XS; const bf16_t* Bt; int K, nM, G, c;
    DEV bool next(int i, Unit& u) const {
        const int L = i * G + c; if (L >= nM * 32) return false;
        u.pm = L / 32; u.sub = L % 32; u.pn = 0;
        u.A = XS + (size_t)u.pm * 256 * (32 * 384) + u.sub * 384; u.lda = 32 * 384; u.B = Bt + (size_t)u.sub * 256 * K; u.ldb = K; u.nt = K / 64; return true;
    }
};
struct SchedMerge {
    const bf16_t* WBR; const bf16_t* YS5; const bf16_t* PROJ; int ntiles, G, c;
    DEV bool next(int i, Unit& u) const {
        const int tl = (i / 3) * G + c; if (tl >= ntiles) return false;
        const int k = i % 3; const int x = tl % 8, idx = tl / 8;
        u.pm = x * (ntiles / 32) + idx / 4; u.pn = idx % 4; u.sub = k;
        if (k == 0) { u.A = YS5 + (size_t)u.pm * 256 * 512; u.lda = 512; } else { u.A = PROJ + (size_t)u.pm * 256 * PROJ_LD + (k == 1 ? PC_GO : PC_Z); u.lda = PROJ_LD; }
        u.B = WBR + ((size_t)k * 1024 + u.pn * 256) * 512; u.ldb = 512; u.nt = 8;
        return true;
    }
};

DEV unsigned ssq_fix(float ss) { return (unsigned)(ss * 16384.0f + 0.5f); }
DEV float rstd_of(float raw) { FU x; x.f = raw; return 1.0f / sqrtf((float)x.u * (1.0f / (16384.0f * D)) + EPS); }
DEV float ssq_raw(const unsigned* p) { FU x; x.u = *p; return x.f; }
struct EpiSwiglu { static constexpr bool GU = true, SSQ = false, RV = true, PF = false, SCALE = false; bf16_t* act; const unsigned* ssq_in;
    DEV float rowval(const Unit&, int row) const { return ssq_raw(ssq_in + row); }
    DEV void store_gu(const Unit&, int row, int hid, const float* g, const float* u, float rv) const { const float r = rstd_of(rv); float v[8]; for (int i = 0; i < 8; ++i) v[i] = silu(g[i] * r) * (u[i] * r); st_bf8(act + (size_t)row * DFFP + hid, v); } };
struct EpiResid { static constexpr bool GU = false, SSQ = true, RV = false, PF = true, SCALE = false; const bf16_t* hb_src; bf16_t* hb_dst; float scale; unsigned* ssq;
    DEV float rowval(const Unit&, int) const { return 0.f; }
    DEV void prefetch(const Unit&, int row, int col, U4& a, U4& b, float& c) const { a = *(const U4*)(hb_src + (size_t)row * D + col); b = a; c = 0.f; }
    DEV float store8p(const Unit&, int row, int col, const float* v, float, const U4& a, const U4&, float) const { float s[8], o[8], ss = 0.f; up_bf8(a, s);
        for (int i = 0; i < 8; ++i) { o[i] = bf2f(f2bf(s[i] + scale * v[i])); ss += o[i] * o[i]; }
        st_bf8(hb_dst + (size_t)row * D + col, o); return ss; }
    DEV float store8(const Unit& u, int row, int col, const float* v, float rv) const { U4 a, b; float c; prefetch(u, row, col, a, b, c); return store8p(u, row, col, v, rv, a, b, c); } };
struct EpiWin { static constexpr bool GU = false, SSQ = false, RV = true, PF = false, SCALE = false; bf16_t* XS; bf16_t* PROJ; float* SMALL; bf16_t* GATES; const unsigned* ssq_in;
    DEV float rowval(const Unit&, int row) const { return ssq_raw(ssq_in + row); }
    DEV void store8(const Unit& u, int row, int col, const float* vin, float rv) const { const float r = rstd_of(rv); float v[8]; for (int i = 0; i < 8; ++i) v[i] = vin[i] * r;
        if (u.pn < 2) st_bf8(XS + ((size_t)(row >> 4) * 32 + (col >> 4)) * 384 + (row & 15) * 16 + (col & 15), v);
        else if (u.pn < 14) st_bf8(PROJ + (size_t)row * PROJ_LD + (col - 512), v);
        else if (u.pn == 14) { const int c = col - 3584; if (c < 32) st_f8(SMALL + (size_t)row * 32 + c, v); }
        else { float t[8]; for (int i = 0; i < 8; ++i) t[i] = fmaxf(sigm(v[i]), 1e-6f); st_bf8(GATES + (size_t)row * 3072 + (col - 3840), t); } } };
struct EpiS5P1 { static constexpr bool GU = false, SSQ = false, RV = false, PF = false, SCALE = false; float* S5S;
    DEV float rowval(const Unit&, int) const { return 0.f; }
    DEV void store8(const Unit& u, int row, int col, const float* v, float) const { if (col < 128) st_f8(S5S + ((size_t)row * 32 + u.sub) * 128 + col, v); } };
struct EpiS5P3 { static constexpr bool GU = false, SSQ = false, RV = false, PF = false, SCALE = false; bf16_t* GS5;
    DEV float rowval(const Unit&, int) const { return 0.f; }
    DEV void store8(const Unit& u, int row, int col, const float* v, float) const { float o[8]; for (int i = 0; i < 8; ++i) o[i] = gelu_t(v[i]); st_bf8(GS5 + ((size_t)row * 16 + (col >> 4)) * 512 + u.sub * 16 + (col & 15), o); } };
struct EpiGlu { static constexpr bool GU = false, SSQ = false, RV = false, PF = true, SCALE = false; const bf16_t* GS5; bf16_t* YS5;
    DEV float rowval(const Unit&, int) const { return 0.f; }
    DEV void prefetch(const Unit&, int row, int col, U4& a, U4& b, float& c) const { a = *(const U4*)(GS5 + (size_t)row * 512 + col); b = a; c = 0.f; }
    DEV float store8p(const Unit&, int row, int col, const float* v, float, const U4& a, const U4&, float) const { float g[8], o[8]; up_bf8(a, g); for (int i = 0; i < 8; ++i) o[i] = g[i] * sigm(v[i]); st_bf8(YS5 + (size_t)row * 512 + col, o); return 0.f; }
    DEV void store8(const Unit& u, int row, int col, const float* v, float rv) const { U4 a, b; float c; prefetch(u, row, col, a, b, c); (void)store8p(u, row, col, v, rv, a, b, c); } };
struct EpiMerge { static constexpr bool GU = false, SSQ = false, RV = false, PF = true, SCALE = true; const bf16_t* GATES; bf16_t* MG;
    DEV float rowval(const Unit&, int) const { return 0.f; }
    DEV void prefetch(const Unit& u, int row, int col, U4& a, U4& b, float& c) const { a = *(const U4*)(GATES + (size_t)row * 3072 + u.sub * 1024 + col);
        if (u.sub < 2) b = *(const U4*)(GATES + (size_t)row * 3072 + (u.sub + 1) * 1024 + col); else b = a; c = 0.f; }
    DEV void ratio8(const U4& a, const U4& b, float* r) const { float g0[8], g1[8]; up_bf8(a, g0); up_bf8(b, g1); for (int i = 0; i < 8; ++i) r[i] = g0[i] * FRCP(g1[i]); }
    DEV float store8p(const Unit&, int row, int col, const float* v, float, const U4& a, const U4&, float) const { float g[8], t[8]; up_bf8(a, g);
        for (int i = 0; i < 8; ++i) t[i] = g[i] * v[i]; st_bf8(MG + (size_t)row * D + col, t); return 0.f; }
    DEV void store8(const Unit& u, int row, int col, const float* v, float rv) const { U4 a, b; float c; prefetch(u, row, col, a, b, c); (void)store8p(u, row, col, v, rv, a, b, c); } };
struct EpiBf { static constexpr bool GU = false, SSQ = false, RV = false, PF = false, SCALE = false; bf16_t* O; int ld;
    DEV float rowval(const Unit&, int) const { return 0.f; }
    DEV void store8(const Unit&, int row, int col, const float* v, float) const { st_bf8(O + (size_t)row * ld + col, v); } };
struct EpiPle { static constexpr bool GU = false, SSQ = true, RV = false, PF = true, SCALE = false; const bf16_t* hb_src; bf16_t* PPb; bf16_t* hb_dst; const unsigned* ssq_in; unsigned* ssq;
    DEV float rowval(const Unit&, int) const { return 0.f; }
    DEV void prefetch(const Unit& u, int row, int col, U4& a, U4& b, float& c) const { const size_t off = (size_t)row * D + col;
        if (u.sub == 0) { a.x = a.y = a.z = a.w = 0u; b = a; c = 0.f; } else { a = *(const U4*)(hb_src + off); b = *(const U4*)(PPb + off); c = ssq_raw(ssq_in + row); } }
    DEV float store8p(const Unit& u, int row, int col, const float* v, float, const U4& a, const U4& b, float c) const { const size_t off = (size_t)row * D + col;
        if (u.sub == 0) { st_bf8(PPb + off, v); return 0.f; }
        const float r = rstd_of(c); float s[8], p[8], o[8], ss = 0.f; up_bf8(a, s); up_bf8(b, p); for (int i = 0; i < 8; ++i) { o[i] = bf2f(f2bf(s[i] + sigm(v[i] * r) * p[i])); ss += o[i] * o[i]; }
        st_bf8(hb_dst + off, o); return ss; }
    DEV float store8(const Unit& u, int row, int col, const float* v, float rv) const { U4 a, b; float c; prefetch(u, row, col, a, b, c); return store8p(u, row, col, v, rv, a, b, c); } };
struct SchedPle { const bf16_t* PB; const bf16_t* WPP; const bf16_t* HB; const bf16_t* WPG; int ntiles, G, c;
    DEV bool next(int i, Unit& u) const {
        const int tl = (i >> 1) * G + c; if (tl >= ntiles) return false;
        u.sub = i & 1; u.pm = tl >> 2; u.pn = tl & 3;
        if (u.sub == 0) { u.A = PB + (size_t)u.pm * 256 * PLE; u.lda = PLE; u.B = WPP + (size_t)u.pn * 256 * PLE; u.ldb = PLE; u.nt = PLE / 64; }
        else { u.A = HB + (size_t)u.pm * 256 * D; u.lda = D; u.B = WPG + (size_t)u.pn * 256 * D; u.ldb = D; u.nt = D / 64; }
        return true; } };

#ifndef CPU_EMU
#define LAS __attribute__((address_space(3)))
typedef short bf16x8 __attribute__((ext_vector_type(8)));
typedef float f32x4 __attribute__((ext_vector_type(4)));
constexpr int HTB = 128 * 64 * 2;
__device__ __forceinline__ int lds_byte(int r, int c) { const int st = (r >> 4) * 2 + (c >> 5), rr = r & 15, cc = c & 31, ob = rr * 64 + cc * 2; return st * 1024 + (ob ^ (((ob >> 9) & 1) << 5)); }
__device__ __forceinline__ void stage_rc(int b, int& R, int& C) { const int st = b / 1024, sb = b % 1024, swz = sb ^ (((sb >> 9) & 1) << 5); R = (st >> 1) * 16 + swz / 64; C = (st & 1) * 32 + (swz % 64) / 2; }
__device__ __forceinline__ int perm32(int rho) { const int n = rho >> 4, i = rho & 15; return 8 * (i >> 2) + 4 * n + (i & 3); }

template <class E> __device__ __forceinline__ void epi_apply(const E& e, const f32x4 (&acc)[2][2][4][2], const Unit& u, int wr, int wc, int fr, int fq, const float (&rs)[8]) {
    if constexpr (E::GU) {
#pragma unroll
        for (int ai = 0; ai < 2; ++ai)
#pragma unroll
            for (int m = 0; m < 4; ++m) { const int row = u.pm * 256 + ai * 128 + wr * 64 + m * 16 + fr; float g[8], uu[8];
#pragma unroll
                for (int j = 0; j < 4; ++j) { g[j] = acc[ai][0][m][0][j]; g[4 + j] = acc[ai][0][m][1][j]; uu[j] = acc[ai][1][m][0][j]; uu[4 + j] = acc[ai][1][m][1][j]; }
                e.store_gu(u, row, u.pn * 128 + wc * 32 + 8 * fq, g, uu, rs[ai * 4 + m]); }
    } else if constexpr (E::PF) {
#pragma unroll
        for (int ai = 0; ai < 2; ++ai) {
            U4 pa[8], pb[8]; float pc[8];
#pragma unroll
            for (int q = 0; q < 8; ++q) { const int row = u.pm * 256 + ai * 128 + wr * 64 + (q >> 1) * 16 + fr, col = u.pn * 256 + (q & 1) * 128 + wc * 32 + 8 * fq; e.prefetch(u, row, col, pa[q], pb[q], pc[q]); }
#pragma unroll
            for (int m = 0; m < 4; ++m) { const int row = u.pm * 256 + ai * 128 + wr * 64 + m * 16 + fr; float ss = 0.f;
#pragma unroll
                for (int bj = 0; bj < 2; ++bj) { const int col = u.pn * 256 + bj * 128 + wc * 32 + 8 * fq; float v[8];
#pragma unroll
                    for (int j = 0; j < 4; ++j) { v[j] = acc[ai][bj][m][0][j]; v[4 + j] = acc[ai][bj][m][1][j]; }
                    ss += e.store8p(u, row, col, v, rs[ai * 4 + m], pa[m * 2 + bj], pb[m * 2 + bj], pc[m * 2 + bj]); }
                if constexpr (E::SSQ) { ss += __shfl_xor(ss, 16, 64); ss += __shfl_xor(ss, 32, 64); if (fq == 0) atomicAdd(e.ssq + row, ssq_fix(ss)); } } }
    } else {
#pragma unroll
        for (int ai = 0; ai < 2; ++ai)
#pragma unroll
            for (int m = 0; m < 4; ++m)
            { const int row = u.pm * 256 + ai * 128 + wr * 64 + m * 16 + fr; float ss = 0.f;
#pragma unroll
                for (int bj = 0; bj < 2; ++bj) { const int col = u.pn * 256 + bj * 128 + wc * 32 + 8 * fq; float v[8];
#pragma unroll
                    for (int j = 0; j < 4; ++j) { v[j] = acc[ai][bj][m][0][j]; v[4 + j] = acc[ai][bj][m][1][j]; }
                    if constexpr (E::SSQ) ss += e.store8(u, row, col, v, rs[ai * 4 + m]); else e.store8(u, row, col, v, rs[ai * 4 + m]); }
                if constexpr (E::SSQ) { ss += __shfl_xor(ss, 16, 64); ss += __shfl_xor(ss, 32, 64); if (fq == 0) atomicAdd(e.ssq + row, ssq_fix(ss)); } }
    }
}

template <class E> __device__ __forceinline__ void scale_apply(const E& e, f32x4 (&acc)[2][2][4][2], const Unit& u, int wr, int wc, int fr, int fq) {
#pragma unroll
    for (int ai = 0; ai < 2; ++ai) {
        U4 pa[8], pb[8]; float pc;
#pragma unroll
        for (int q = 0; q < 8; ++q) { const int row = u.pm * 256 + ai * 128 + wr * 64 + (q >> 1) * 16 + fr, col = u.pn * 256 + (q & 1) * 128 + wc * 32 + 8 * fq; e.prefetch(u, row, col, pa[q], pb[q], pc); }
#pragma unroll
        for (int m = 0; m < 4; ++m)
#pragma unroll
            for (int bj = 0; bj < 2; ++bj) { float r[8]; e.ratio8(pa[m * 2 + bj], pb[m * 2 + bj], r);
#pragma unroll
                for (int j = 0; j < 4; ++j) { acc[ai][bj][m][0][j] *= r[j]; acc[ai][bj][m][1][j] *= r[4 + j]; } } }
}
template <class Epi, class Sched>
__device__ __forceinline__ void gemm_phase(const Ctx& ctx, const Sched& S, const Epi& E) {
    LAS unsigned char* lds = (LAS unsigned char*)ctx.smem;
    const int tid = ctx.tid, wid = __builtin_amdgcn_readfirstlane(tid >> 6), lane = tid & 63, wr = wid >> 2, wc = wid & 3, fr = lane & 15, fq = lane >> 4;
    int RA[2], RB[2], CC[2];
#pragma unroll
    for (int i = 0; i < 2; ++i) { int R, C; stage_rc(tid * 16 + i * 8192, R, C); RA[i] = R; RB[i] = (R & ~31) + perm32(R & 31); CC[i] = C; }
    const size_t kstep = 128;
    const unsigned ldsw = (unsigned)wid * 1024u;
    const int aoff = lds_byte(wr * 64 + fr, fq * 8), boff = lds_byte(wc * 32 + fr, fq * 8);
#define G_SA(b, h) (((b) * 2 + (h)) * HTB)
#define G_SB(b, h) ((4 + (b) * 2 + (h)) * HTB)
#define G_STAGE(bufoff, gbase, RR, ld) do { _Pragma("unroll") for (int _i = 0; _i < 2; ++_i) \
        __builtin_amdgcn_global_load_lds((const unsigned*)((const char*)(gbase) + (size_t)((unsigned)(RR[_i] * (ld) + CC[_i]) * 2u)), (LAS unsigned*)(lds + (bufoff) + ldsw + _i * 8192), 16, 0, 0); } while (0)
#define G_LDA(dst, b, h) do { _Pragma("unroll") for (int m = 0; m < 4; ++m) _Pragma("unroll") for (int k = 0; k < 2; ++k) dst[m][k] = *(const LAS bf16x8*)(lds + G_SA(b, h) + aoff + m * 2048 + k * 1024); } while (0)
#define G_LDB(dst, b, h) do { _Pragma("unroll") for (int n = 0; n < 2; ++n) _Pragma("unroll") for (int k = 0; k < 2; ++k) dst[n][k] = *(const LAS bf16x8*)(lds + G_SB(b, h) + boff + n * 2048 + k * 1024); } while (0)
#define G_MMA(ai, bj, At, Bt) do { __builtin_amdgcn_s_setprio(1); _Pragma("unroll") for (int m = 0; m < 4; ++m) _Pragma("unroll") for (int n = 0; n < 2; ++n) _Pragma("unroll") for (int k = 0; k < 2; ++k) \
        acc[ai][bj][m][n] = __builtin_amdgcn_mfma_f32_16x16x32_bf16(Bt[n][k], At[m][k], acc[ai][bj][m][n], 0, 0, 0); __builtin_amdgcn_s_setprio(0); } while (0)
#define G_WAIT_V(n) asm volatile("s_waitcnt vmcnt(" #n ")" ::: "memory")
#define G_WAIT_L(n) asm volatile("s_waitcnt lgkmcnt(" #n ")" ::: "memory")
#define G_BAR __builtin_amdgcn_s_barrier()
#define G_SCHED __builtin_amdgcn_sched_barrier(0)
    Unit cur, nxt; int ui = 0;
    if (!S.next(0, cur)) return;
    f32x4 acc[2][2][4][2];
#pragma unroll
    for (int a = 0; a < 2; ++a)
#pragma unroll
        for (int b = 0; b < 2; ++b)
#pragma unroll
            for (int m = 0; m < 4; ++m)
#pragma unroll
                for (int n = 0; n < 2; ++n) acc[a][b][m][n] = (f32x4){0.f, 0.f, 0.f, 0.f};
    bf16x8 At[4][2], B0[2][2], B1[2][2];
    float rs[8] = {0.f, 0.f, 0.f, 0.f, 0.f, 0.f, 0.f, 0.f};
    const char* cA = (const char*)cur.A; const char* cB = (const char*)cur.B; int lda = cur.lda, ldb = cur.ldb, nt = cur.nt;
    {
        const size_t hA = (size_t)128 * lda * 2, hB = (size_t)128 * ldb * 2;
        G_STAGE(G_SB(0, 0), cB, RB, ldb); G_STAGE(G_SA(0, 0), cA, RA, lda); G_STAGE(G_SB(0, 1), cB + hB, RB, ldb); G_STAGE(G_SA(0, 1), cA + hA, RA, lda);
        if (wr == 1) G_BAR;
        G_WAIT_V(4); G_BAR;
        G_STAGE(G_SB(1, 0), cB + kstep, RB, ldb); G_STAGE(G_SA(1, 0), cA + kstep, RA, lda); G_STAGE(G_SB(1, 1), cB + hB + kstep, RB, ldb);
        G_WAIT_V(6); G_BAR;
    }
    for (;;) {
        const bool has_next = S.next(ui + 1, nxt);
        const char* nA = has_next ? (const char*)nxt.A : cA; const char* nB = has_next ? (const char*)nxt.B : cB;
        const int nlda = has_next ? nxt.lda : lda, nldb = has_next ? nxt.ldb : ldb;
        const size_t hA = (size_t)128 * lda * 2;
        for (int t = 0; t < nt; t += 2) {
            const bool last = (t == nt - 2);
            if constexpr (Epi::RV) { if (last) {
#pragma unroll
                for (int q = 0; q < 8; ++q) rs[q] = E.rowval(cur, cur.pm * 256 + (q >> 2) * 128 + wr * 64 + (q & 3) * 16 + fr); } }
            const char* a1 = cA + (size_t)(t + 1) * kstep;
            const char* a2 = last ? nA : cA + (size_t)(t + 2) * kstep; const char* b2 = last ? nB : cB + (size_t)(t + 2) * kstep;
            const int lda2 = last ? nlda : lda, ldb2 = last ? nldb : ldb;
            const size_t hA2 = (size_t)128 * lda2 * 2, hB2 = (size_t)128 * ldb2 * 2;
            const char* a3 = a2 + kstep; const char* b3 = b2 + kstep;
            G_LDB(B0, 0, 0); G_SCHED; G_LDA(At, 0, 0); G_STAGE(G_SA(1, 1), a1 + hA, RA, lda);
            G_WAIT_L(8); G_BAR; G_WAIT_L(0); G_MMA(0, 0, At, B0); G_BAR; G_SCHED;
            G_LDB(B1, 0, 1); G_STAGE(G_SB(0, 0), b2, RB, ldb2);
            G_BAR; G_WAIT_L(0); G_MMA(0, 1, At, B1); G_BAR;
            G_LDA(At, 0, 1); G_STAGE(G_SA(0, 0), a2, RA, lda2);
            G_BAR; G_WAIT_L(0); G_MMA(1, 0, At, B0); G_BAR; G_SCHED;
            G_STAGE(G_SB(0, 1), b2 + hB2, RB, ldb2);
            G_WAIT_V(6); G_BAR; G_MMA(1, 1, At, B1); G_BAR;
            G_LDB(B0, 1, 0); G_SCHED; G_LDA(At, 1, 0); G_STAGE(G_SA(0, 1), a2 + hA2, RA, lda2);
            G_WAIT_L(8); G_BAR; G_WAIT_L(0); G_MMA(0, 0, At, B0); G_BAR; G_SCHED;
            G_LDB(B1, 1, 1); G_STAGE(G_SB(1, 0), b3, RB, ldb2);
            G_BAR; G_WAIT_L(0); G_MMA(0, 1, At, B1); G_BAR;
            G_LDA(At, 1, 1); G_STAGE(G_SA(1, 0), a3, RA, lda2);
            G_BAR; G_WAIT_L(0); G_MMA(1, 0, At, B0); G_BAR; G_SCHED;
            G_STAGE(G_SB(1, 1), b3 + hB2, RB, ldb2);
            G_WAIT_V(6); G_BAR; G_MMA(1, 1, At, B1); G_BAR;
        }
        bool keep = false;
        if constexpr (Epi::SCALE) { keep = cur.sub < 2; if (keep) scale_apply(E, acc, cur, wr, wc, fr, fq); else epi_apply(E, acc, cur, wr, wc, fr, fq, rs); }
        else epi_apply(E, acc, cur, wr, wc, fr, fq, rs);
        if (!has_next) break;
        if (!keep)
#pragma unroll
        for (int a = 0; a < 2; ++a)
#pragma unroll
            for (int b = 0; b < 2; ++b)
#pragma unroll
                for (int m = 0; m < 4; ++m)
#pragma unroll
                    for (int n = 0; n < 2; ++n) acc[a][b][m][n] = (f32x4){0.f, 0.f, 0.f, 0.f};
        cur = nxt; cA = nA; cB = nB; lda = nlda; ldb = nldb; nt = cur.nt; ++ui;
    }
    G_WAIT_V(0);
    if (wr == 0) G_BAR;
    G_BAR;
}
#else
template <class Epi, class Sched>
inline void gemm_phase(const Ctx& ctx, const Sched& S, const Epi& E) {
    Unit u;
    static thread_local float carry[256 * 256];
    for (int i = 0; S.next(i, u); ++i) {
        const int K = u.nt * 64;
        for (int r = 0; r < 256; ++r) {
            float arow[4096]; for (int k = 0; k < K; ++k) arow[k] = bf2f(u.A[(size_t)r * u.lda + k]);
            if constexpr (Epi::GU) {
                for (int c0 = 0; c0 < 128; c0 += 8) { float g[8], uu[8];
                    for (int j = 0; j < 8; ++j) { float sg = 0, su = 0; const bf16_t* bg = u.B + (size_t)(c0 + j) * u.ldb; const bf16_t* bu = u.B + (size_t)(128 + c0 + j) * u.ldb;
                        for (int k = 0; k < K; ++k) { sg += arow[k] * bf2f(bg[k]); su += arow[k] * bf2f(bu[k]); } g[j] = sg; uu[j] = su; }
                    E.store_gu(u, u.pm * 256 + r, u.pn * 128 + c0, g, uu, E.rowval(u, u.pm * 256 + r)); }
            } else {
                for (int c0 = 0; c0 < 256; c0 += 8) { float v[8];
                    for (int j = 0; j < 8; ++j) { float s = 0; const bf16_t* b = u.B + (size_t)(c0 + j) * u.ldb; for (int k = 0; k < K; ++k) s += arow[k] * bf2f(b[k]); v[j] = s; }
                    if constexpr (Epi::SCALE) { float* cr = carry + r * 256 + c0; if (u.sub > 0) for (int j = 0; j < 8; ++j) v[j] += cr[j];
                        if (u.sub < 2) { U4 a, b2; float c; float rt[8]; E.prefetch(u, u.pm * 256 + r, u.pn * 256 + c0, a, b2, c); E.ratio8(a, b2, rt); for (int j = 0; j < 8; ++j) cr[j] = v[j] * rt[j]; continue; } }
                    if constexpr (Epi::SSQ) { const float q = E.store8(u, u.pm * 256 + r, u.pn * 256 + c0, v, E.rowval(u, u.pm * 256 + r));
#pragma omp atomic
                        E.ssq[u.pm * 256 + r] += ssq_fix(q); } else E.store8(u, u.pm * 256 + r, u.pn * 256 + c0, v, E.rowval(u, u.pm * 256 + r)); }
            }
        }
    }
}
#endif

template <class F> DEV void mm_nt(const bf16_t* As, int lda, const bf16_t* Bs, int ldb, int M, int N, int K, int causal, const Ctx& ctx, F epi) {
    const int ntn = N / 16, ntiles = (M / 16) * ntn;
#ifndef CPU_EMU
    const int wave = ctx.tid >> 6, lane = ctx.tid & 63, nw = ctx.nthr >> 6, r = lane & 15, q = lane >> 4;
    for (int t = wave; t < ntiles; t += nw) {
        const int tm = t / ntn, tn = t % ntn; const int lim = (tm * 16 + 16 + 31) & ~31;
        if (causal == 1 && tn * 16 >= lim) continue;
        const int kend = (causal == 2 && lim < K) ? lim : K;
        f32x4 acc = {0.f, 0.f, 0.f, 0.f};
        const bf16_t* ap = As + (tm * 16 + r) * lda + q * 8; const bf16_t* bp = Bs + (tn * 16 + r) * ldb + q * 8;
        for (int k0 = 0; k0 < kend; k0 += 32) { const bf16x8 a = *(const bf16x8*)(ap + k0); const bf16x8 b = *(const bf16x8*)(bp + k0); acc = __builtin_amdgcn_mfma_f32_16x16x32_bf16(a, b, acc, 0, 0, 0); }
#pragma unroll
        for (int j = 0; j < 4; ++j) epi(tm * 16 + q * 4 + j, tn * 16 + r, acc[j]);
    }
#else
    for (int t = 0; t < ntiles; ++t) {
        const int tm = t / ntn, tn = t % ntn; const int lim = (tm * 16 + 16 + 31) & ~31;
        if (causal == 1 && tn * 16 >= lim) continue;
        const int kend = (causal == 2 && lim < K) ? lim : K;
        for (int i = 0; i < 16; ++i) for (int j = 0; j < 16; ++j) { float s = 0; for (int k = 0; k < kend; ++k) s += bf2f(As[(tm * 16 + i) * lda + k]) * bf2f(Bs[(tn * 16 + j) * ldb + k]); epi(tm * 16 + i, tn * 16 + j, s); }
    }
#endif
}

DEV void conv_job(const Ctx& ctx, const float* src, int sld, int scol0, int ncols, int Ksrc, bf16_t* dst, int dld, int njpad, int Kdst, const float* scale, int mode) {
    float* tile = (float*)ctx.smem;
    const int tilesJ = njpad / 128, tilesK = Kdst / 64, ntl = tilesJ * tilesK;
    const int ncv = ctx.nblk > 64 ? ctx.nblk - 32 : ctx.nblk;
    if (ctx.bid >= ncv) return;
    for (int tl = ctx.bid; tl < ntl; tl += ncv) {
        const int j0 = (tl % tilesJ) * 128, k0 = (tl / tilesJ) * 64;
        for (int e = ctx.tid; e < 2048; e += ctx.nthr) { const int kk = e >> 5, jj = (e & 31) * 4, k = k0 + kk, j = j0 + jj; F4 v; v.x = v.y = v.z = v.w = 0.f;
            if (mode == 3) { if (k < Ksrc) { float t[4]; for (int u = 0; u < 4; ++u) { const int jq = j + u; t[u] = jq < 24 ? src[(size_t)k * sld + (jq < 16 ? 2048 + jq : 3600 + (jq - 16))] : 0.f; } v.x = t[0]; v.y = t[1]; v.z = t[2]; v.w = t[3]; } }
            else if (j < ncols && k < Ksrc) v = *(const F4*)(src + (size_t)k * sld + scol0 + j);
            if (scale && k < Ksrc) { const float sc = scale[k]; v.x *= sc; v.y *= sc; v.z *= sc; v.w *= sc; }
            float* tp = tile + kk * 129 + jj; tp[0] = v.x; tp[1] = v.y; tp[2] = v.z; tp[3] = v.w; }
        SYNC();
        for (int e = ctx.tid; e < 1024; e += ctx.nthr) { const int jj = e >> 3, kv = (e & 7) * 8, j = j0 + jj; int row = j;
            if (mode == 1) row = (j >> 7) * 256 + (j & 127); else if (mode == 2) row = (j >> 7) * 256 + 128 + (j & 127);
            float o[8];
#pragma unroll
            for (int u = 0; u < 8; ++u) o[u] = tile[(kv + u) * 129 + jj];
            st_bf8(dst + (size_t)row * dld + k0 + kv, o); }
        SYNC();
    }
}

DEV void s5_prep_item(const Ctx& ctx, PRM P, int l, int g, bf16_t* BT1, bf16_t* BT3, float* LAM) {
    float* sm = (float*)ctx.smem;
    float* PwR = sm; float* PwI = PwR + 17 * 64; float* BbR = PwI + 17 * 64; float* BbI = BbR + 1024; float* CR = BbI + 1024; float* CI = CR + 1024; float* Kt = CI + 1024;
    const float* lam_re = P.in[8] + ((size_t)l * 32 + g) * 64; const float* lam_im = P.in[9] + ((size_t)l * 32 + g) * 64;
    const float step = expf(P.in[10][l * 32 + g]);
    const float* b_re = P.in[11] + ((size_t)l * 32 + g) * 1024; const float* b_im = P.in[12] + ((size_t)l * 32 + g) * 1024;
    const float* c_re = P.in[13] + ((size_t)l * 32 + g) * 1024; const float* c_im = P.in[14] + ((size_t)l * 32 + g) * 1024;
    const float* dsk = P.in[15] + (size_t)l * 512 + g * 16;
    for (int e = ctx.tid; e < 17 * 64; e += ctx.nthr) { const int tau = e / 64, p = e % 64; const float lr = fminf(lam_re[p], -1e-4f), li = lam_im[p];
        const float mg = expf(lr * step * tau), an = li * step * tau; PwR[e] = mg * cosf(an); PwI[e] = mg * sinf(an); }
    for (int e = ctx.tid; e < 1024; e += ctx.nthr) { const int p = e / 16; const float lr = fminf(lam_re[p], -1e-4f), li = lam_im[p];
        const float mg = expf(lr * step), ar = mg * cosf(li * step), ai = mg * sinf(li * step), den = lr * lr + li * li, nr = ar - 1.f;
        const float fr = (nr * lr + ai * li) / den, fi = (ai * lr - nr * li) / den; const float br = b_re[e], bi = b_im[e];
        BbR[e] = fr * br - fi * bi; BbI[e] = fr * bi + fi * br; CR[e] = c_re[e]; CI[e] = c_im[e]; }
    SYNC();
    for (int e = ctx.tid; e < 4096; e += ctx.nthr) { const int tau = e >> 8, h = (e >> 4) & 15, h2 = e & 15; float s = 0.f;
        for (int p = 0; p < 64; ++p) { const float cr = CR[h * 64 + p], ci = CI[h * 64 + p], pr = PwR[tau * 64 + p], pi = PwI[tau * 64 + p];
            const float er = cr * pr - ci * pi, ei = cr * pi + ci * pr; s += er * BbR[p * 16 + h2] - ei * BbI[p * 16 + h2]; }
        Kt[e] = s; }
    SYNC();
    bf16_t* b3 = BT3 + (size_t)g * 256 * 384;
    for (int e = ctx.tid; e < 256 * 384; e += ctx.nthr) { const int n = e / 384, k = e % 384, t = n >> 4, h = n & 15; float v = 0.f;
        if (k < 256) { const int j = k >> 4, h2 = k & 15; if (j <= t) { v = Kt[((t - j) << 8) + (h << 4) + h2]; if (j == t && h == h2) v += dsk[h]; } }
        else { const int kk = k - 256, p = kk & 63; const float cr = CR[h * 64 + p], ci = CI[h * 64 + p], pr = PwR[(t + 1) * 64 + p], pi = PwI[(t + 1) * 64 + p];
            v = kk < 64 ? (cr * pr - ci * pi) : -(cr * pi + ci * pr); }
        b3[e] = f2bf(v); }
    bf16_t* b1 = BT1 + (size_t)g * 256 * 256;
    for (int e = ctx.tid; e < 256 * 256; e += ctx.nthr) { const int n = e >> 8, k = e & 255, j = k >> 4, h2 = k & 15; float v = 0.f;
        if (n < 128) { const int p = n & 63; const float pr = PwR[(15 - j) * 64 + p], pi = PwI[(15 - j) * 64 + p], br = BbR[p * 16 + h2], bi = BbI[p * 16 + h2];
            v = n < 64 ? (pr * br - pi * bi) : (pr * bi + pi * br); }
        b1[e] = f2bf(v); }
    for (int p = ctx.tid; p < 64; p += ctx.nthr) { LAM[(g * 64 + p) * 2] = PwR[16 * 64 + p]; LAM[(g * 64 + p) * 2 + 1] = PwI[16 * 64 + p]; }
    SYNC();
}

DEV void phase_pconv(const Ctx& ctx, const float* p, bf16_t* dst);
DEV void phase_conv(const Ctx& ctx, PRM P, int l) {
    unsigned char* ws = P.ws;
    const size_t gu = (size_t)D * DFF;
    conv_job(ctx, P.in[3] + l * gu, DFF, 0, DFF, D, (bf16_t*)(ws + W_GU1), D, DFFP, D, P.in[2] + l * D, 1);
    conv_job(ctx, P.in[4] + l * gu, DFF, 0, DFF, D, (bf16_t*)(ws + W_GU1), D, DFFP, D, P.in[2] + l * D, 2);
    conv_job(ctx, P.in[5] + l * gu, D, 0, D, DFF, (bf16_t*)(ws + W_D1), DFFP, D, DFFP, nullptr, 0);
    conv_job(ctx, P.in[31] + l * gu, DFF, 0, DFF, D, (bf16_t*)(ws + W_GU2), D, DFFP, D, P.in[30] + l * D, 1);
    conv_job(ctx, P.in[32] + l * gu, DFF, 0, DFF, D, (bf16_t*)(ws + W_GU2), D, DFFP, D, P.in[30] + l * D, 2);
    conv_job(ctx, P.in[33] + l * gu, D, 0, D, DFF, (bf16_t*)(ws + W_D2), DFFP, D, DFFP, nullptr, 0);
    const float* win = P.in[7] + (size_t)l * D * IN_TOTAL; const float* mn = P.in[6] + l * D; bf16_t* bin = (bf16_t*)(ws + W_IN);
    conv_job(ctx, win, IN_TOTAL, 0, 2048, D, bin, D, 2048, D, mn, 0);
    conv_job(ctx, win, IN_TOTAL, 2064, 1536, D, bin + (size_t)2048 * D, D, 1536, D, mn, 0);
    conv_job(ctx, win, IN_TOTAL, 0, 0, D, bin + (size_t)3584 * D, D, 256, D, mn, 3);
    conv_job(ctx, win, IN_TOTAL, 3608, 3072, D, (bf16_t*)(ws + W_G), D, 3072, D, mn, 0);
    conv_job(ctx, P.in[16] + (size_t)l * 512 * 512, 512, 0, 512, 512, (bf16_t*)(ws + W_GLU), 512, 512, 512, nullptr, 0);
    for (int k = 0; k < 3; ++k) conv_job(ctx, P.in[26 + k] + (size_t)l * 512 * D, D, 0, D, 512, (bf16_t*)(ws + W_BR) + (size_t)k * 1024 * 512, 512, D, 512, nullptr, 0);
    conv_job(ctx, P.in[29] + (size_t)l * D * D, D, 0, D, D, (bf16_t*)(ws + W_OUT), D, D, D, nullptr, 0);
    conv_job(ctx, P.in[35] + (size_t)l * D * D, D, 0, D, D, (bf16_t*)(ws + W_PG), D, D, D, P.in[34] + l * D, 0);
    conv_job(ctx, P.in[36] + (size_t)l * PLE * D, D, 0, D, PLE, (bf16_t*)(ws + W_PP), PLE, D, PLE, nullptr, 0);
    if (l == 0) { float* q = (float*)(ws + O_SSQ) + T; for (size_t i = (size_t)ctx.bid * ctx.nthr + ctx.tid; i < (size_t)8 * T; i += (size_t)ctx.nblk * ctx.nthr) q[i] = 0.f; }
    phase_pconv(ctx, P.in[1] + (size_t)l * T * PLE, (bf16_t*)(ws + O_PB));
    for (int g = ctx.nblk - 1 - ctx.bid; g < 32; g += ctx.nblk) s5_prep_item(ctx, P, l, g, (bf16_t*)(ws + W_S1), (bf16_t*)(ws + W_S3), (float*)(ws + W_LAM));
}

#ifndef CPU_EMU
__device__ __forceinline__ float wave_sum(float v) {
#pragma unroll
    for (int o = 32; o > 0; o >>= 1) v += __shfl_xor(v, o, 64);
    return v;
}
#endif
DEV void phase_norm(const Ctx& ctx, const float* src, bf16_t* dst, unsigned* ssq, int rows) {
#ifndef CPU_EMU
    const int lane = ctx.tid & 63, gw = ctx.bid * (ctx.nthr >> 6) + (ctx.tid >> 6), nw = ctx.nblk * (ctx.nthr >> 6);
    for (int row = gw; row < rows; row += nw) { const F4* s4 = (const F4*)(src + (size_t)row * D); F4 v[4]; float ss = 0.f;
#pragma unroll
        for (int i = 0; i < 4; ++i) { v[i] = s4[i * 64 + lane]; ss += v[i].x * v[i].x + v[i].y * v[i].y + v[i].z * v[i].z + v[i].w * v[i].w; }
        ss = wave_sum(ss); if (lane == 0) ssq[row] = ssq_fix(ss);
#pragma unroll
        for (int i = 0; i < 4; ++i) { unsigned* d = (unsigned*)(dst + (size_t)row * D + (i * 64 + lane) * 4); d[0] = pack2(v[i].x, v[i].y); d[1] = pack2(v[i].z, v[i].w); } }
#else
    for (int row = ctx.bid; row < rows; row += ctx.nblk) { float ss = 0; for (int i = 0; i < D; ++i) { const float x = src[(size_t)row * D + i]; ss += x * x; dst[(size_t)row * D + i] = f2bf(x); } ssq[row] = ssq_fix(ss); }
#endif
}
DEV void phase_final(const Ctx& ctx, const bf16_t* hb, float* out, const float* w, const unsigned* ssq, int rows) {
    const size_t n8 = (size_t)rows * (D / 8);
    for (size_t i = (size_t)ctx.bid * ctx.nthr + ctx.tid; i < n8; i += (size_t)ctx.nblk * ctx.nthr) { const int row = (int)(i >> 7), c8 = (int)(i & 127) * 8; const float r = rstd_of(ssq_raw(ssq + row));
        float v[8], ww[8], o[8]; ld_bf8(hb + i * 8, v); ld_f8(w + c8, ww); for (int u = 0; u < 8; ++u) o[u] = v[u] * r * ww[u]; st_f8(out + i * 8, o); }
}
DEV void phase_pconv(const Ctx& ctx, const float* p, bf16_t* dst) {
    const size_t n8 = (size_t)T * PLE / 8;
    for (size_t i = (size_t)ctx.bid * ctx.nthr + ctx.tid; i < n8; i += (size_t)ctx.nblk * ctx.nthr) { float v[8]; ld_f8(p + i * 8, v); st_bf8(dst + i * 8, v); }
}
DEV void phase_s5scan(const Ctx& ctx, bf16_t* XS, const float* S5S, const float* LAM) {
    for (int t2 = ctx.tid; t2 < 64; t2 += ctx.nthr)
        for (int idx = ctx.bid * 64 + t2; idx < SEQH * 32 * 64; idx += ctx.nblk * 64) {
            const int p = idx & 63, g = (idx >> 6) & 31, b = idx >> 11; const float ar = LAM[(g * 64 + p) * 2], ai = LAM[(g * 64 + p) * 2 + 1]; float hr = 0.f, hi = 0.f;
            float ar_[16], ai_[16], br_[16], bi_[16];
#define S5_LOAD(R, I, c0) { _Pragma("unroll") for (int u = 0; u < 16; ++u) { const size_t base = (size_t)(b * NCH16 + (c0) + u) * 32 + g; R[u] = S5S[base * 128 + p]; I[u] = S5S[base * 128 + 64 + p]; } }
#define S5_STEP(R, I, c0) { _Pragma("unroll") for (int u = 0; u < 16; ++u) { const size_t base = (size_t)(b * NCH16 + (c0) + u) * 32 + g; XS[base * 384 + 256 + p] = f2bf(hr); XS[base * 384 + 320 + p] = f2bf(hi); \
                const float nr = ar * hr - ai * hi + R[u], ni = ar * hi + ai * hr + I[u]; hr = nr; hi = ni; } }
            S5_LOAD(ar_, ai_, 0);
            for (int c0 = 0; c0 < NCH16; c0 += 32) { S5_LOAD(br_, bi_, c0 + 16); S5_STEP(ar_, ai_, c0); if (c0 + 32 < NCH16) S5_LOAD(ar_, ai_, c0 + 32); S5_STEP(br_, bi_, c0 + 16); }
#undef S5_LOAD
#undef S5_STEP
        }
}

DEV void gla_gates(const Ctx& ctx, PRM P, int l, const float* SMALL, int row0, int h, float*& bc, float*& la, float* glr, float* w2s, float* b2s) {
    const float* w2 = P.in[17] + (size_t)l * 16 * 256; const float* b2 = P.in[18] + (size_t)l * 256;
    for (int e = ctx.tid; e < 1024; e += ctx.nthr) { glr[e] = SMALL[(size_t)(row0 + (e >> 4)) * 32 + (e & 15)]; w2s[e] = w2[(e >> 6) * 256 + h * 64 + (e & 63)]; }
    for (int e = ctx.tid; e < 64; e += ctx.nthr) b2s[e] = b2[h * 64 + e];
    SYNC();
    for (int e = ctx.tid; e < 4096; e += ctx.nthr) { const int i = e >> 6, k = e & 63; float x = b2s[k];
#pragma unroll
        for (int r = 0; r < 16; ++r) x += glr[i * 16 + r] * w2s[r * 64 + k];
        la[e] = logsig(x) * (1.0f / 16.0f); }
    SYNC();
    for (int e = ctx.tid; e < 512; e += ctx.nthr) { const int blk = e >> 6, k = e & 63; float run = 0.f;
#pragma unroll
        for (int u = 0; u < 8; ++u) { run += la[(blk * 8 + u) * 64 + k]; bc[(blk * 8 + u) * 64 + k] = run; } }
    SYNC();
    for (int e = ctx.tid; e < 4096; e += ctx.nthr) { const int i = e >> 6, k = e & 63, blk = i >> 3; float off = 0.f; for (int b2i = 0; b2i < blk; ++b2i) off += bc[(b2i * 8 + 7) * 64 + k]; la[e] = bc[e] + off; }
    SYNC();
    { float* t = bc; bc = la; la = t; }
}
DEV void gla_a_item(const Ctx& ctx, PRM P, int l, int it, const bf16_t* PROJ, const float* SMALL, float* GST, float* GDEC, float* BCG) {
    const int b = it / (NC64 * 4), c = (it >> 2) % NC64, h = it & 3, row0 = b * SEQ + c * 64;
    float* bc = (float*)ctx.smem; float* la = bc + 4096; float* glr = la + 4096; float* w2s = glr + 1024; float* b2s = w2s + 1024;
    bf16_t* vT = (bf16_t*)(b2s + 64); bf16_t* kdT = vT + 128 * 72;
#ifndef CPU_EMU
    const int ek = ctx.tid, jk = ek >> 3, kk0 = (ek & 7) * 8; const U4 kraw = *(const U4*)(PROJ + (size_t)(row0 + jk) * PROJ_LD + PC_K + h * 64 + kk0);
    U4 vraw[2];
#pragma unroll
    for (int q = 0; q < 2; ++q) { const int e = ctx.tid + q * 512; vraw[q] = *(const U4*)(PROJ + (size_t)(row0 + (e >> 4)) * PROJ_LD + PC_V + h * 128 + (e & 15) * 8); }
#endif
    gla_gates(ctx, P, l, SMALL, row0, h, bc, la, glr, w2s, b2s);
    { float* bg = BCG + (size_t)it * 4096; for (int e = ctx.tid; e < 512; e += ctx.nthr) { float t[8]; for (int u = 0; u < 8; ++u) t[u] = bc[e * 8 + u]; st_f8(bg + e * 8, t); } }
#ifndef CPU_EMU
    { float kv[8]; up_bf8(kraw, kv);
#pragma unroll
        for (int u = 0; u < 8; ++u) kdT[(kk0 + u) * 72 + jk] = f2bf(kv[u] * FEXP(bc[63 * 64 + kk0 + u] - bc[jk * 64 + kk0 + u])); }
#else
    for (int e = ctx.tid; e < 512; e += ctx.nthr) { const int j = e >> 3, k0 = (e & 7) * 8; float kv[8]; ld_bf8(PROJ + (size_t)(row0 + j) * PROJ_LD + PC_K + h * 64 + k0, kv);
        for (int u = 0; u < 8; ++u) kdT[(k0 + u) * 72 + j] = f2bf(kv[u] * FEXP(bc[63 * 64 + k0 + u] - bc[j * 64 + k0 + u])); }
#endif
#ifndef CPU_EMU
#pragma unroll
    for (int q = 0; q < 2; ++q) { const int e = ctx.tid + q * 512, j = e >> 4, d0 = (e & 15) * 8; const U4 w = vraw[q];
#else
    for (int e = ctx.tid; e < 1024; e += ctx.nthr) { const int j = e >> 4, d0 = (e & 15) * 8; const U4 w = *(const U4*)(PROJ + (size_t)(row0 + j) * PROJ_LD + PC_V + h * 128 + d0);
#endif
        vT[(d0 + 0) * 72 + j] = (bf16_t)(w.x & 0xffff); vT[(d0 + 1) * 72 + j] = (bf16_t)(w.x >> 16); vT[(d0 + 2) * 72 + j] = (bf16_t)(w.y & 0xffff); vT[(d0 + 3) * 72 + j] = (bf16_t)(w.y >> 16);
        vT[(d0 + 4) * 72 + j] = (bf16_t)(w.z & 0xffff); vT[(d0 + 5) * 72 + j] = (bf16_t)(w.z >> 16); vT[(d0 + 6) * 72 + j] = (bf16_t)(w.w & 0xffff); vT[(d0 + 7) * 72 + j] = (bf16_t)(w.w >> 16); }
    SYNC();
    float* st = GST + ((size_t)(b * 4 + h) * NC64 + c) * 8192;
    mm_nt(vT, 72, kdT, 72, 128, 64, 64, 0, ctx, [&](int i, int j, float v) { st[i * 64 + j] = v; });
    for (int k = ctx.tid; k < 64; k += ctx.nthr) GDEC[((size_t)(b * 4 + h) * NC64 + c) * 64 + k] = FEXP(bc[63 * 64 + k]);
    SYNC();
}
DEV void phase_gla_scan(const Ctx& ctx, float* GST, const float* GDEC) {
    const int total = SEQH * 4 * 8192;
    for (int idx = ctx.bid * ctx.nthr + ctx.tid; idx < total; idx += ctx.nblk * ctx.nthr) {
        const int bh = idx >> 13, e = idx & 8191; float* base = GST + (size_t)bh * NC64 * 8192 + e; const float* dec = GDEC + (size_t)bh * NC64 * 64 + (e & 63); float run = 0.f;
        float la_[8], da_[8], lb_[8], db_[8];
#define GS_LOAD(L, Dv, c0) { _Pragma("unroll") for (int u = 0; u < 8; ++u) { L[u] = base[(size_t)((c0) + u) * 8192]; Dv[u] = dec[((c0) + u) * 64]; } }
#define GS_STEP(L, Dv, c0) { _Pragma("unroll") for (int u = 0; u < 8; ++u) { base[(size_t)((c0) + u) * 8192] = run; run = Dv[u] * run + L[u]; } }
        GS_LOAD(la_, da_, 0);
        for (int c0 = 0; c0 < NC64; c0 += 16) { GS_LOAD(lb_, db_, c0 + 8); GS_STEP(la_, da_, c0); if (c0 + 16 < NC64) GS_LOAD(la_, da_, c0 + 16); GS_STEP(lb_, db_, c0 + 8); }
#undef GS_LOAD
#undef GS_STEP
    }
}
DEV void gla_c_item(const Ctx& ctx, PRM P, int l, int it, bf16_t* PROJ, const float* BCG, const float* GST) {
    const int b = it / (NC64 * 4), c = (it >> 2) % NC64, h = it & 3, row0 = b * SEQ + c * 64;
    float* bc = (float*)ctx.smem; float* la = bc + 4096; float* glr = la + 4096; float* w2s = glr + 1024; float* b2s = w2s + 1024; u64* ssq = (u64*)(b2s + 64);
    bf16_t* As = (bf16_t*)(ssq + 64); bf16_t* ks = As + 64 * 136; bf16_t* Bs = ks + 64 * 72; float* o = la;
    o = (float*)(Bs + 128 * 136);
    const float* st = GST + ((size_t)(b * 4 + h) * NC64 + c) * 8192;
#ifndef CPU_EMU
    U4 graw[2];
    { const int e0 = ctx.tid, i = e0 >> 3, k0 = (e0 & 7) * 8; const size_t r = (size_t)(row0 + i) * PROJ_LD; float bcv[8], qv[8], kv[8], qo[8], ko[8], s0[8], s1[8];
        ld_f8(BCG + (size_t)it * 4096 + e0 * 8, bcv); const U4 qraw = *(const U4*)(PROJ + r + PC_Q + h * 64 + k0); const U4 kraw = *(const U4*)(PROJ + r + PC_K + h * 64 + k0);
        ld_f8(st + e0 * 8, s0); ld_f8(st + (e0 + 512) * 8, s1);
        U4 vraw[2];
#pragma unroll
        for (int q = 0; q < 2; ++q) { const int e = e0 + q * 512; vraw[q] = *(const U4*)(PROJ + (size_t)(row0 + (e >> 4)) * PROJ_LD + PC_V + h * 128 + (e & 15) * 8);
            graw[q] = *(const U4*)(PROJ + (size_t)(row0 + (e >> 4)) * PROJ_LD + PC_GO + h * 128 + (e & 15) * 8); }
        up_bf8(qraw, qv); up_bf8(kraw, kv);
#pragma unroll
        for (int u = 0; u < 8; ++u) { qo[u] = qv[u] * 0.125f * FEXP(bcv[u]); ko[u] = kv[u] * FEXP(-bcv[u]); }
        st_bf8(As + i * 136 + k0, qo); st_bf8(ks + i * 72 + k0, ko);
        st_bf8(Bs + (e0 >> 3) * 136 + (e0 & 7) * 8, s0); st_bf8(Bs + ((e0 + 512) >> 3) * 136 + (e0 & 7) * 8, s1);
#pragma unroll
        for (int q = 0; q < 2; ++q) { const int e = e0 + q * 512, j = e >> 4, d0 = (e & 15) * 8; const U4 w = vraw[q]; bf16_t* bp = Bs + d0 * 136 + 64 + j;
            bp[0] = (bf16_t)(w.x & 0xffff); bp[136] = (bf16_t)(w.x >> 16); bp[2 * 136] = (bf16_t)(w.y & 0xffff); bp[3 * 136] = (bf16_t)(w.y >> 16);
            bp[4 * 136] = (bf16_t)(w.z & 0xffff); bp[5 * 136] = (bf16_t)(w.z >> 16); bp[6 * 136] = (bf16_t)(w.w & 0xffff); bp[7 * 136] = (bf16_t)(w.w >> 16); } }
#else
    { const float* bg = BCG + (size_t)it * 4096; for (int e = ctx.tid; e < 512; e += ctx.nthr) { float t[8]; ld_f8(bg + e * 8, t); for (int u = 0; u < 8; ++u) bc[e * 8 + u] = t[u]; } }
    for (int e = ctx.tid; e < 512; e += ctx.nthr) { const int i = e >> 3, k0 = (e & 7) * 8; const size_t r = (size_t)(row0 + i) * PROJ_LD; float qv[8], kv[8], qo[8], ko[8];
        ld_bf8(PROJ + r + PC_Q + h * 64 + k0, qv); ld_bf8(PROJ + r + PC_K + h * 64 + k0, kv);
        for (int u = 0; u < 8; ++u) { const float bb = bc[i * 64 + k0 + u]; qo[u] = qv[u] * 0.125f * FEXP(bb); ko[u] = kv[u] * FEXP(-bb); }
        st_bf8(As + i * 136 + k0, qo); st_bf8(ks + i * 72 + k0, ko); }
    for (int e = ctx.tid; e < 1024; e += ctx.nthr) { const int dv = e >> 3, k0 = (e & 7) * 8; float sv[8]; ld_f8(st + dv * 64 + k0, sv); st_bf8(Bs + dv * 136 + k0, sv); }
    for (int e = ctx.tid; e < 1024; e += ctx.nthr) { const int j = e >> 4, d0 = (e & 15) * 8; const U4 w = *(const U4*)(PROJ + (size_t)(row0 + j) * PROJ_LD + PC_V + h * 128 + d0);
        bf16_t* bp = Bs + d0 * 136 + 64 + j;
        bp[0] = (bf16_t)(w.x & 0xffff); bp[136] = (bf16_t)(w.x >> 16); bp[2 * 136] = (bf16_t)(w.y & 0xffff); bp[3 * 136] = (bf16_t)(w.y >> 16);
        bp[4 * 136] = (bf16_t)(w.z & 0xffff); bp[5 * 136] = (bf16_t)(w.z >> 16); bp[6 * 136] = (bf16_t)(w.w & 0xffff); bp[7 * 136] = (bf16_t)(w.w >> 16); }
#endif
    for (int i = ctx.tid; i < 64; i += ctx.nthr) ssq[i] = 0;
    SYNC();
    mm_nt(As, 136, ks, 72, 64, 64, 64, 0, ctx, [&](int i, int j, float v) { As[i * 136 + 64 + j] = (j <= i) ? f2bf(v) : (bf16_t)0; });
    SYNC();
    mm_nt(As, 136, Bs, 136, 64, 128, 128, 0, ctx, [&](int i, int j, float v) { o[i * 132 + j] = v; LDS_ADD(&ssq[i], fx24(v * v)); });
    SYNC();
    const float* gn = P.in[19] + (size_t)l * 128;
#ifndef CPU_EMU
#pragma unroll
    for (int q = 0; q < 2; ++q) { const int e = ctx.tid + q * 512, i = e >> 4, d0 = (e & 15) * 8; bf16_t* gp = PROJ + (size_t)(row0 + i) * PROJ_LD + PC_GO + h * 128 + d0; float gv[8], ov[8];
        up_bf8(graw[q], gv);
#else
    for (int e = ctx.tid; e < 1024; e += ctx.nthr) { const int i = e >> 4, d0 = (e & 15) * 8; bf16_t* gp = PROJ + (size_t)(row0 + i) * PROJ_LD + PC_GO + h * 128 + d0; float gv[8], ov[8];
        ld_bf8(gp, gv);
#endif
        const float r = 1.0f / sqrtf(unfx24(ssq[i]) * (1.0f / 128) + EPS);
#pragma unroll
        for (int u = 0; u < 8; ++u) ov[u] = o[i * 132 + d0 + u] * r * gn[d0 + u] * silu(gv[u]);
        st_bf8(gp, ov); }
    SYNC();
}

DEV void phase_ssd_conv(const Ctx& ctx, PRM P, int l, const bf16_t* PROJ, bf16_t* XC) {
    const float* cw = P.in[20] + (size_t)l * 4096; const float* cb = P.in[21] + (size_t)l * 1024;
    const int total = (TH / 8) * 128;
    for (int idx = ctx.bid * ctx.nthr + ctx.tid; idx < total; idx += ctx.nblk * ctx.nthr) {
        const int cg = idx & 127, r0 = (idx >> 7) * 8, ch = cg * 8; float w[4][8], bias[8], win[3][8];
#pragma unroll
        for (int k = 0; k < 4; ++k) ld_f8(cw + k * 1024 + ch, w[k]);
        ld_f8(cb + ch, bias);
        const bool first = (r0 % SEQ) == 0;
#pragma unroll
        for (int k = 0; k < 3; ++k) { if (first) { for (int u = 0; u < 8; ++u) win[k][u] = 0.f; } else ld_bf8(PROJ + (size_t)(r0 - 3 + k) * PROJ_LD + PC_X + ch, win[k]); }
#pragma unroll
        for (int j = 0; j < 8; ++j) { float cur[8], o[8]; ld_bf8(PROJ + (size_t)(r0 + j) * PROJ_LD + PC_X + ch, cur);
#pragma unroll
            for (int u = 0; u < 8; ++u) { o[u] = silu(bias[u] + w[0][u] * win[0][u] + w[1][u] * win[1][u] + w[2][u] * win[2][u] + w[3][u] * cur[u]); win[0][u] = win[1][u]; win[1][u] = win[2][u]; win[2][u] = cur[u]; }
            st_bf8(XC + (size_t)(r0 + j) * 1024 + ch, o); }
    }
}
DEV void ssd_dtcum(const Ctx& ctx, PRM P, int l, const float* SMALL, int row0, int g, float* dt, float* cum, float* la) {
    for (int e = ctx.tid; e < 512; e += ctx.nthr) { const int h4 = e >> 7, i = e & 127, hd = g * 4 + h4; const float d = softplus(SMALL[(size_t)(row0 + i) * 32 + 16 + hd] + P.in[22][l * 8 + hd]);
        dt[e] = d; la[e] = d * -FEXP(P.in[23][l * 8 + hd]); }
    SYNC();
    for (int e = ctx.tid; e < 512; e += ctx.nthr) { const int i = e & 127, base = e - i; float run = 0.f; for (int u = 0; u <= i; ++u) run += la[base + u]; cum[e] = run; }
    SYNC();
}
DEV void ssd_a_item(const Ctx& ctx, PRM P, int l, int it, const bf16_t* XC, const float* SMALL, float* SST, float* SDEC) {
    const int b = it / (NC128 * 2), c = (it >> 1) % NC128, g = it & 1, row0 = b * SEQ + c * 128;
    float* dt = (float*)ctx.smem; float* cum = dt + 512; float* la = cum + 512; bf16_t* BT = (bf16_t*)(la + 512); bf16_t* xdT = BT + 128 * 136;
    ssd_dtcum(ctx, P, l, SMALL, row0, g, dt, cum, la);
    for (int e = ctx.tid; e < 2048; e += ctx.nthr) { const int i = e >> 4, n0 = (e & 15) * 8; const U4 w = *(const U4*)(XC + (size_t)(row0 + i) * 1024 + 512 + g * 128 + n0); bf16_t* bp = BT + n0 * 136 + i;
        bp[0] = (bf16_t)(w.x & 0xffff); bp[136] = (bf16_t)(w.x >> 16); bp[2 * 136] = (bf16_t)(w.y & 0xffff); bp[3 * 136] = (bf16_t)(w.y >> 16);
        bp[4 * 136] = (bf16_t)(w.z & 0xffff); bp[5 * 136] = (bf16_t)(w.z >> 16); bp[6 * 136] = (bf16_t)(w.w & 0xffff); bp[7 * 136] = (bf16_t)(w.w >> 16); }
    for (int e = ctx.tid; e < 4096; e += ctx.nthr) { const int i = e >> 5, q0 = (e & 31) * 8, h4 = q0 >> 6; float xv[8]; ld_bf8(XC + (size_t)(row0 + i) * 1024 + g * 256 + q0, xv);
        const float sc = dt[h4 * 128 + i] * FEXP(cum[h4 * 128 + 127] - cum[h4 * 128 + i]);
#pragma unroll
        for (int u = 0; u < 8; ++u) xdT[(q0 + u) * 136 + i] = f2bf(xv[u] * sc); }
    SYNC();
    float* st = SST + ((size_t)(b * 8 + g * 4) * NC128) * 8192;
    mm_nt(xdT, 136, BT, 136, 256, 128, 128, 0, ctx, [&](int i, int j, float v) { st[((size_t)(i >> 6) * NC128 + c) * 8192 + (i & 63) * 128 + j] = v; });
    for (int h4 = ctx.tid; h4 < 4; h4 += ctx.nthr) SDEC[(size_t)(b * 8 + g * 4 + h4) * NC128 + c] = FEXP(cum[h4 * 128 + 127]);
    SYNC();
}
DEV void phase_ssd_scan(const Ctx& ctx, float* SST, const float* SDEC) {
    const int total = SEQH * 8 * 8192;
    for (int idx = ctx.bid * ctx.nthr + ctx.tid; idx < total; idx += ctx.nblk * ctx.nthr) {
        const int bh = idx >> 13, e = idx & 8191; float* base = SST + (size_t)bh * NC128 * 8192 + e; const float* dec = SDEC + (size_t)bh * NC128; float run = 0.f;
        float la_[8], lb_[8];
#define SS_LOAD(L, c0) { _Pragma("unroll") for (int u = 0; u < 8; ++u) L[u] = base[(size_t)((c0) + u) * 8192]; }
#define SS_STEP(L, c0) { _Pragma("unroll") for (int u = 0; u < 8; ++u) { base[(size_t)((c0) + u) * 8192] = run; run = dec[(c0) + u] * run + L[u]; } }
        SS_LOAD(la_, 0);
        for (int c0 = 0; c0 < NC128; c0 += 16) { SS_LOAD(lb_, c0 + 8); SS_STEP(la_, c0); if (c0 + 16 < NC128) SS_LOAD(la_, c0 + 16); SS_STEP(lb_, c0 + 8); }
#undef SS_LOAD
#undef SS_STEP
    }
}
template <int M, int N, class F> DEV void mm_nt2(const bf16_t* A1, const bf16_t* B1, const float* rowscale, const bf16_t* A2, const bf16_t* B2, int ld, int K, const Ctx& ctx, F epi) {
    constexpr int ntn = N / 16, ntiles = (M / 16) * ntn;
#ifndef CPU_EMU
    const int wave = ctx.tid >> 6, lane = ctx.tid & 63, r = lane & 15, q = lane >> 4;
#pragma unroll
    for (int tt = 0; tt < ntiles / 8; ++tt) {
        const int t = wave + tt * 8, tm = t / ntn, tn = t % ntn; const int lim = (tm * 16 + 16 + 31) & ~31; const int kend = lim < K ? lim : K;
        f32x4 acc = {0.f, 0.f, 0.f, 0.f};
        const bf16_t* ap = A1 + (tm * 16 + r) * ld + q * 8; const bf16_t* bp = B1 + (tn * 16 + r) * ld + q * 8;
        for (int k0 = 0; k0 < K; k0 += 32) acc = __builtin_amdgcn_mfma_f32_16x16x32_bf16(*(const bf16x8*)(ap + k0), *(const bf16x8*)(bp + k0), acc, 0, 0, 0);
#pragma unroll
        for (int j = 0; j < 4; ++j) acc[j] *= rowscale[tm * 16 + q * 4 + j];
        ap = A2 + (tm * 16 + r) * ld + q * 8; bp = B2 + (tn * 16 + r) * ld + q * 8;
        for (int k0 = 0; k0 < kend; k0 += 32) acc = __builtin_amdgcn_mfma_f32_16x16x32_bf16(*(const bf16x8*)(ap + k0), *(const bf16x8*)(bp + k0), acc, 0, 0, 0);
#pragma unroll
        for (int j = 0; j < 4; ++j) epi(tm * 16 + q * 4 + j, tn * 16 + r, acc[j], tt * 4 + j);
    }
#else
    for (int t = 0; t < ntiles; ++t) {
        const int tm = t / ntn, tn = t % ntn; const int lim = (tm * 16 + 16 + 31) & ~31; const int kend = lim < K ? lim : K;
        for (int i = 0; i < 16; ++i) for (int j = 0; j < 16; ++j) { float s = 0; for (int k = 0; k < K; ++k) s += bf2f(A1[(tm * 16 + i) * ld + k]) * bf2f(B1[(tn * 16 + j) * ld + k]);
            s *= rowscale[tm * 16 + i]; for (int k = 0; k < kend; ++k) s += bf2f(A2[(tm * 16 + i) * ld + k]) * bf2f(B2[(tn * 16 + j) * ld + k]); epi(tm * 16 + i, tn * 16 + j, s, -1); }
    }
#endif
}
template <class F> DEV void mm_foreach(int M, int N, const Ctx& ctx, F f) {
    const int ntn = N / 16, ntiles = (M / 16) * ntn;
#ifndef CPU_EMU
    const int wave = ctx.tid >> 6, lane = ctx.tid & 63, nw = ctx.nthr >> 6, r = lane & 15, q = lane >> 4;
    for (int t = wave; t < ntiles; t += nw) { const int tm = t / ntn, tn = t % ntn;
#pragma unroll
        for (int j = 0; j < 4; ++j) f(tm * 16 + q * 4 + j, tn * 16 + r); }
#else
    for (int t = 0; t < ntiles; ++t) { const int tm = t / ntn, tn = t % ntn; for (int i = 0; i < 16; ++i) for (int j = 0; j < 16; ++j) f(tm * 16 + i, tn * 16 + j); }
#endif
}
DEV void ssd_c_item(const Ctx& ctx, PRM P, int l, int it, bf16_t* PROJ, const bf16_t* XC, const float* SMALL, const float* SST) {
    const int b = it / (NC128 * 2), c = (it >> 1) % NC128, g = it & 1, row0 = b * SEQ + c * 128;
    float* dt = (float*)ctx.smem; float* cum = dt + 512; float* la = cum + 512; u64* ssq = (u64*)(la + 512); float* ecum = (float*)(ssq + 128);
    bf16_t* Cs = (bf16_t*)(ecum + 128); bf16_t* Bs = Cs + 128 * 136; bf16_t* Sb = Bs + 128 * 136; bf16_t* xsT = Sb + 128 * 136; bf16_t* hin = xsT + 64 * 136; bf16_t* W = Bs;
    ssd_dtcum(ctx, P, l, SMALL, row0, g, dt, cum, la);
    for (int e = ctx.tid; e < 2048; e += ctx.nthr) { const int i = e >> 4, n0 = (e & 15) * 8; const bf16_t* src = XC + (size_t)(row0 + i) * 1024 + 512 + g * 128 + n0;
        *(U4*)(Bs + i * 136 + n0) = *(const U4*)src; *(U4*)(Cs + i * 136 + n0) = *(const U4*)(src + 256); }
    for (int i = ctx.tid; i < 128; i += ctx.nthr) ssq[i] = 0;
    SYNC();
    mm_nt(Cs, 136, Bs, 136, 128, 128, 128, 1, ctx, [&](int i, int j, float v) { Sb[i * 136 + j] = f2bf(v); });
    SYNC();
#ifndef CPU_EMU
    float yv[4][16];
    const int wave_ = ctx.tid >> 6, lane_ = ctx.tid & 63, r_ = lane_ & 15, q_ = lane_ >> 4;
#endif
#pragma unroll
    for (int h4 = 0; h4 < 4; ++h4) {
        const int hd = g * 4 + h4; const float* cm = cum + h4 * 128; const float* dth = dt + h4 * 128;
#ifndef CPU_EMU
        float zv[16];
#pragma unroll
        for (int tt = 0; tt < 4; ++tt) { const int t = wave_ + tt * 8, tm = t >> 2, tn = t & 3;
#pragma unroll
            for (int j = 0; j < 4; ++j) zv[tt * 4 + j] = bf2f(PROJ[(size_t)(row0 + tm * 16 + q_ * 4 + j) * PROJ_LD + PC_Z + hd * 64 + tn * 16 + r_]); }
#endif
        for (int e = ctx.tid; e < 2048; e += ctx.nthr) { const int i = e >> 4, m0 = (e & 15) * 8; const int lim = ((i & ~15) + 16 + 31) & ~31;
            if (m0 < lim) { float sv[8], wv[8]; ld_bf8(Sb + i * 136 + m0, sv); const float ci = cm[i];
#pragma unroll
                for (int u = 0; u < 8; ++u) { const int m = m0 + u; wv[u] = (m <= i) ? sv[u] * FEXP(ci - cm[m]) * dth[m] : 0.f; }
                st_bf8(W + i * 136 + m0, wv); } }
        for (int e = ctx.tid; e < 1024; e += ctx.nthr) { const int i = e >> 3, p0 = (e & 7) * 8; const U4 w = *(const U4*)(XC + (size_t)(row0 + i) * 1024 + hd * 64 + p0); bf16_t* bp = xsT + p0 * 136 + i;
            bp[0] = (bf16_t)(w.x & 0xffff); bp[136] = (bf16_t)(w.x >> 16); bp[2 * 136] = (bf16_t)(w.y & 0xffff); bp[3 * 136] = (bf16_t)(w.y >> 16);
            bp[4 * 136] = (bf16_t)(w.z & 0xffff); bp[5 * 136] = (bf16_t)(w.z >> 16); bp[6 * 136] = (bf16_t)(w.w & 0xffff); bp[7 * 136] = (bf16_t)(w.w >> 16); }
        const float* st = SST + ((size_t)(b * 8 + hd) * NC128 + c) * 8192;
        for (int e = ctx.tid; e < 1024; e += ctx.nthr) { const int p = e >> 4, n0 = (e & 15) * 8; float sv[8]; ld_f8(st + p * 128 + n0, sv); st_bf8(hin + p * 136 + n0, sv); }
        for (int i = ctx.tid; i < 128; i += ctx.nthr) ecum[i] = FEXP(cm[i]);
        SYNC();
        const float dsk = P.in[24][l * 8 + hd];
        mm_nt2<128, 64>(Cs, hin, ecum, W, xsT, 136, 128, ctx, [&](int i, int j, float v, int slot) {
#ifndef CPU_EMU
            const float y = bf2f(f2bf((v + dsk * bf2f(xsT[j * 136 + i])) * silu(zv[slot]))); yv[h4][slot] = y; LDS_ADD(&ssq[i], fx24(y * y));
#else
            bf16_t* zp = PROJ + (size_t)(row0 + i) * PROJ_LD + PC_Z + hd * 64 + j; const bf16_t yb = f2bf((v + dsk * bf2f(xsT[j * 136 + i])) * silu(bf2f(*zp)));
            *zp = yb; const float y = bf2f(yb); LDS_ADD(&ssq[i], fx24(y * y)); (void)slot;
#endif
        });
        SYNC();
    }
    const float* nw = P.in[25] + (size_t)l * 512 + g * 256;
#ifndef CPU_EMU
#pragma unroll
    for (int h4 = 0; h4 < 4; ++h4)
#pragma unroll
        for (int tt = 0; tt < 4; ++tt) { const int t = wave_ + tt * 8, tm = t >> 2, tn = t & 3;
#pragma unroll
            for (int j = 0; j < 4; ++j) { const int i = tm * 16 + q_ * 4 + j, col = h4 * 64 + tn * 16 + r_;
                PROJ[(size_t)(row0 + i) * PROJ_LD + PC_Z + g * 256 + col] = f2bf(yv[h4][tt * 4 + j] * (1.0f / sqrtf(unfx24(ssq[i]) * (1.0f / 256) + EPS)) * nw[col]); } }
#else
    for (int h4 = 0; h4 < 4; ++h4)
        mm_foreach(128, 64, ctx, [&](int i, int j) { bf16_t* zp = PROJ + (size_t)(row0 + i) * PROJ_LD + PC_Z + (g * 4 + h4) * 64 + j;
            *zp = f2bf(bf2f(*zp) * (1.0f / sqrtf(unfx24(ssq[i]) * (1.0f / 256) + EPS)) * nw[h4 * 64 + j]); });
#endif
    SYNC();
}

constexpr int PH_L0 = 19, PH_L1 = 19, PH_TOTAL = PH_L0 + PH_L1 + 1;
DEV void run_phase(const Ctx& ctx, PRM P, int ph) {
    unsigned char* ws = P.ws; unsigned* SSQ = (unsigned*)(ws + O_SSQ); unsigned char* osc = (unsigned char*)P.out;
    if (ph < 0) return;
    if (ph == PH_TOTAL - 1) { phase_final(ctx, (bf16_t*)(ws + O_HB), P.out, P.in[37], SSQ + (size_t)8 * T, T); return; }
    int l = 0, s = ph; if (ph >= PH_L0) { l = 1; s = ph - PH_L0; } if (s >= 1) s += 1;
    bf16_t* HB = (bf16_t*)(ws + (l == 0 ? O_HB : O_HB2)); bf16_t* HBN = (bf16_t*)(ws + (l == 0 ? O_HB2 : O_HB));
    unsigned* ssq1 = SSQ + (size_t)(l * 4 + 0) * T; unsigned* ssq2 = ssq1 + T; unsigned* ssq3 = ssq2 + T; unsigned* ssq4 = ssq3 + T; unsigned* ssq5 = ssq4 + T;
    if (s == 0) { phase_conv(ctx, P, l); if (l == 0) phase_norm(ctx, P.in[0], HB, ssq1, T); return; }
    if (s == 1) return;
    if (s == 2 || s == 17) { SchedSimple S; S.init(HB, D, (bf16_t*)(ws + (s == 2 ? W_GU1 : W_GU2)), D, T, NGU, D, ctx.nblk, ctx.bid); EpiSwiglu E{(bf16_t*)(ws + O_ACT), s == 2 ? ssq1 : ssq3}; gemm_phase(ctx, S, E); return; }
    if (s == 3 || s == 18) { SchedSimple S; S.init((bf16_t*)(ws + O_ACT), DFFP, (bf16_t*)(ws + (s == 3 ? W_D1 : W_D2)), DFFP, T, D, DFFP, ctx.nblk, ctx.bid); EpiResid E{HB, HB, 0.5f, s == 3 ? ssq2 : ssq4}; gemm_phase(ctx, S, E); return; }
    if (s == 19) { SchedPle S{(bf16_t*)(ws + O_PB), (bf16_t*)(ws + W_PP), HB, (bf16_t*)(ws + W_PG), (T / 256) * 4, ctx.nblk, ctx.bid}; EpiPle E{HB, (bf16_t*)(ws + O_PP), HBN, ssq4, ssq5}; gemm_phase(ctx, S, E); return; }
    const int half = s <= 10 ? 0 : 1, lv = s <= 10 ? s - 4 : s - 10;
    bf16_t* HBh = HB + (size_t)half * TH * D;
    bf16_t* PROJ = (bf16_t*)(ws + O_PROJ); float* SMALL = (float*)(ws + O_SMALL); bf16_t* XS = (bf16_t*)(ws + O_XS); float* S5S = (float*)(ws + O_S5S);
    bf16_t* GS5 = (bf16_t*)(osc + OUT_GS5); bf16_t* YS5 = (bf16_t*)(osc + OUT_YS5); bf16_t* GATES = (bf16_t*)(osc + OUT_GATES); float* GST = (float*)(ws + O_GST); float* GDEC = (float*)(ws + O_GDEC);
    float* SST = (float*)(ws + O_SST); float* SDEC = (float*)(ws + O_SDEC); bf16_t* SG = (bf16_t*)(ws + O_SG); bf16_t* MG = (bf16_t*)(ws + O_MG);
    if (lv == 0) { SchedSimple S; S.init(HBh, D, (bf16_t*)(ws + W_IN), D, TH, IN_N + 3072, D, ctx.nblk, ctx.bid); EpiWin E{XS, PROJ, SMALL, GATES, ssq2 + (size_t)half * TH}; gemm_phase(ctx, S, E); return; }
    bf16_t* XC = (bf16_t*)(ws + O_SG);
    if (lv == 1) {
        { SchedS5 S{XS, (bf16_t*)(ws + W_S1), 256, CHH / 256, ctx.nblk, ctx.bid}; EpiS5P1 E{S5S}; gemm_phase(ctx, S, E); }
        phase_ssd_conv(ctx, P, l, PROJ, XC);
        for (int it = ctx.bid; it < SEQH * NC64 * 4; it += ctx.nblk) gla_a_item(ctx, P, l, it, PROJ, SMALL, GST, GDEC, (float*)(ws + O_BCG));
        return; }
    if (lv == 2) { for (int it = ctx.bid; it < SEQH * NC128 * 2; it += ctx.nblk) ssd_a_item(ctx, P, l, it, XC, SMALL, SST, SDEC);
        phase_s5scan(ctx, XS, S5S, (const float*)(ws + W_LAM)); phase_gla_scan(ctx, GST, GDEC); return; }
    if (lv == 3) {
        { SchedS5 S{XS, (bf16_t*)(ws + W_S3), 384, CHH / 256, ctx.nblk, ctx.bid}; EpiS5P3 E{GS5}; gemm_phase(ctx, S, E); }
        phase_ssd_scan(ctx, SST, SDEC);
        for (int it = ctx.bid; it < SEQH * NC64 * 4; it += ctx.nblk) gla_c_item(ctx, P, l, it, PROJ, (const float*)(ws + O_BCG), GST);
        return; }
    if (lv == 4) { { SchedSimple S; S.init(GS5, 512, (bf16_t*)(ws + W_GLU), 512, TH, 512, 512, ctx.nblk, ctx.bid); EpiGlu E{GS5, YS5}; gemm_phase(ctx, S, E); }
        for (int it = ctx.bid; it < SEQH * NC128 * 2; it += ctx.nblk) ssd_c_item(ctx, P, l, it, PROJ, XC, SMALL, SST); return; }
    if (lv == 5) { SchedMerge S{(bf16_t*)(ws + W_BR), YS5, PROJ, (TH / 256) * 4, ctx.nblk, ctx.bid}; EpiMerge E{GATES, MG}; gemm_phase(ctx, S, E); return; }
    if (lv == 6) { { SchedSimple S; S.init(MG, D, (bf16_t*)(ws + W_OUT), D, TH, D, D, ctx.nblk, ctx.bid); EpiResid E{HBh, HBh, 1.0f, ssq3 + (size_t)half * TH}; gemm_phase(ctx, S, E); }
        if (half == 0) { bf16_t* HB1 = HB + (size_t)TH * D;
            SchedSimple S; S.init(HB1, D, (bf16_t*)(ws + W_IN), D, TH, IN_N + 3072, D, ctx.nblk, ctx.bid); EpiWin E{XS, PROJ, SMALL, GATES, ssq2 + (size_t)TH}; gemm_phase(ctx, S, E); }
        return; }
}

#ifndef CPU_EMU
#define XB_TMO      128
#define XB_XCNT(j)  (256  + 64 * (j))
#define XB_XSUB(j)  (1280 + 64 * (j))
#define XB_XGEN(j)  (2304 + 64 * (j))
#define XB_TOP      3328
#define XB_TOPGEN   3392
#define XCD_BAR_WORDS 3456
#define XB_SPIN_CAP (1u << 18)
__device__ __forceinline__ unsigned xb_ld(unsigned* p)              { return __hip_atomic_load(p, __ATOMIC_RELAXED, __HIP_MEMORY_SCOPE_AGENT); }
__device__ __forceinline__ unsigned xb_add(unsigned* p, unsigned v) { return __hip_atomic_fetch_add(p, v, __ATOMIC_RELAXED, __HIP_MEMORY_SCOPE_AGENT); }
__device__ __forceinline__ unsigned xb_xcc_id() { return (unsigned)__builtin_amdgcn_s_getreg((3 << 11) | 20) & 0xFu; }
#define XB_SPIN(cond, bar) do { unsigned _sp = 0; while (cond) { __builtin_amdgcn_s_sleep(1); \
    if ((++_sp & 255u) == 0u) { if (xb_ld(&(bar)[XB_TMO])) break; if (_sp > XB_SPIN_CAP) { atomicAdd(&(bar)[XB_TMO], 1u); break; } } } } while (0)
struct XcdBarrier { unsigned* bar; unsigned x; volatile LAS unsigned* st; };
__device__ __forceinline__ XcdBarrier xcd_barrier_post(unsigned* bar, volatile LAS unsigned* st) {
    XcdBarrier b; b.bar = bar; b.x = xb_xcc_id(); b.st = st;
    if (threadIdx.x == 0) (void)xb_add(&bar[XB_XCNT(b.x)], 1u);
    return b;
}
__device__ __forceinline__ void xcd_barrier_complete(unsigned* bar, unsigned x, unsigned& nloc, unsigned& nx) {
    const unsigned G = gridDim.x * gridDim.y * gridDim.z;
    unsigned sum, cnt, mine, sp = 0u;
    for (;;) {
        sum = 0u; cnt = 0u; mine = 0u;
#pragma unroll
        for (unsigned j = 0; j < 16; ++j) { const unsigned c = xb_ld(&bar[XB_XCNT(j)]); sum += c; cnt += (c > 0u) ? 1u : 0u; mine = (j == x) ? c : mine; }
        if (sum == G) break;
        __builtin_amdgcn_s_sleep(1);
        if ((++sp & 255u) == 0u) { if (xb_ld(&bar[XB_TMO])) break; if (sp > XB_SPIN_CAP) { atomicAdd(&bar[XB_TMO], 1u); break; } }
    }
    nloc = mine > 0u ? mine : 1u; nx = cnt > 0u ? cnt : 1u;
}
__device__ __forceinline__ void xcd_barrier(const XcdBarrier& b) {
    asm volatile("s_waitcnt vmcnt(0)" ::: "memory");
    __syncthreads();
    if (threadIdx.x == 0) {
        unsigned* bar = b.bar;
        __builtin_amdgcn_s_waitcnt(0);
        unsigned nloc = b.st[0], nx = b.st[1];
        if (nloc == 0u) { xcd_barrier_complete(bar, b.x, nloc, nx); b.st[0] = nloc; b.st[1] = nx; }
        const unsigned old = xb_add(&bar[XB_XSUB(b.x)], 1u);
        const unsigned gen = old / nloc;
        if (old + 1u == (gen + 1u) * nloc) {
            __builtin_amdgcn_fence(__ATOMIC_RELEASE, "agent");
            asm volatile("s_waitcnt vmcnt(0)" ::: "memory");
            const unsigned og = xb_add(&bar[XB_TOP], 1u);
            const unsigned tg = og / nx;
            if (og + 1u == (tg + 1u) * nx) xb_add(&bar[XB_TOPGEN], 1u);
            else XB_SPIN(xb_ld(&bar[XB_TOPGEN]) == tg, bar);
            __builtin_amdgcn_fence(__ATOMIC_ACQUIRE, "agent");
            xb_add(&bar[XB_XGEN(b.x)], 1u);
            asm volatile("s_waitcnt vmcnt(0)" ::: "memory");
        } else {
            XB_SPIN(xb_ld(&bar[XB_XGEN(b.x)]) == gen, bar);
            __builtin_amdgcn_fence(__ATOMIC_ACQUIRE, "agent");
            asm volatile("s_waitcnt vmcnt(0)" ::: "memory");
        }
    }
    __syncthreads();
}

__global__ void __launch_bounds__(512) hybrid_megakernel(Params P) {
        extern __shared__ __attribute__((aligned(16))) unsigned char smem[];
    volatile LAS unsigned* xst = (volatile LAS unsigned*)(smem + LDS_BYTES);
    if (threadIdx.x == 0) { xst[0] = 0u; xst[1] = 0u; xst[2] = 0u; xst[3] = 0u; }
    __syncthreads();
    (void)xcd_barrier_post((unsigned*)(P.ws + O_BAR), xst);
#define GRID_SYNC(first) do { if (first) cg::this_grid().sync(); else { XcdBarrier xb_; xb_.bar = (unsigned*)(Pp->ws + O_BAR); xb_.x = xb_xcc_id(); xb_.st = (volatile LAS unsigned*)(smem + LDS_BYTES); xcd_barrier(xb_); } } while (0)
#define STEP(n) { const __attribute__((address_space(4))) Params* Pp = (const __attribute__((address_space(4))) Params*)__builtin_amdgcn_kernarg_segment_ptr(); \
        int tid = threadIdx.x, bid = blockIdx.x, nblk = gridDim.x, smo = 0; \
        asm volatile("" : "+s"(Pp), "+v"(tid), "+s"(bid), "+s"(nblk), "+s"(smo)); \
        Ctx ctx; ctx.bid = bid; ctx.nblk = nblk; ctx.tid = tid; ctx.nthr = 512; ctx.smem = smem + smo; \
        run_phase(ctx, *Pp, (n)); \
        if ((n) + 1 < PH_TOTAL + REP_N) GRID_SYNC((n) == 0); }
#ifndef REP_N
#define REP_N 0
#define REP_PH 0
#endif
    STEP(0) STEP(1) STEP(2) STEP(3) STEP(4) STEP(5) STEP(6) STEP(7) STEP(8) STEP(9) STEP(10) STEP(11) STEP(12) STEP(13) STEP(14) STEP(15) STEP(16) STEP(17) STEP(18) STEP(19) STEP(20)
    STEP(21) STEP(22) STEP(23) STEP(24) STEP(25) STEP(26) STEP(27) STEP(28) STEP(29) STEP(30) STEP(31) STEP(32) STEP(33) STEP(34) STEP(35) STEP(36) STEP(37) STEP(38)
    static_assert(PH_TOTAL == 39, "update the unrolled phase list");
#if REP_N > 0
    for (int r = 0; r < REP_N; ++r) { const __attribute__((address_space(4))) Params* Pp = (const __attribute__((address_space(4))) Params*)__builtin_amdgcn_kernarg_segment_ptr();
        int tid = threadIdx.x, bid = blockIdx.x, nblk = gridDim.x, smo = 0;
        asm volatile("" : "+s"(Pp), "+v"(tid), "+s"(bid), "+s"(nblk), "+s"(smo));
        Ctx ctx; ctx.bid = bid; ctx.nblk = nblk; ctx.tid = tid; ctx.nthr = 512; ctx.smem = smem + smo;
        run_phase(ctx, *Pp, REP_PH);
        if (r + 1 < REP_N) GRID_SYNC(false); }
#endif
}
#endif

#ifndef CPU_EMU
extern "C" void kernel_launch(void* const* d_in, const int* in_sizes, int n_in, void* d_out, int out_size, void* d_ws, size_t ws_size, hipStream_t stream) {
    static int grid_blocks = 0;
    if (grid_blocks == 0) {
        if (n_in != 38 || ws_size < WS_NEED) { fprintf(stderr, "kernel_launch: need 38 inputs and %zu bytes of workspace (got %d, %zu)\n", (size_t)WS_NEED, n_in, ws_size); grid_blocks = -1; return; }
        int dev = 0, cus = 0, per_cu = 0;
        hipGetDevice(&dev);
        hipDeviceGetAttribute(&cus, hipDeviceAttributeMultiprocessorCount, dev);
        hipFuncSetAttribute((const void*)hybrid_megakernel, hipFuncAttributeMaxDynamicSharedMemorySize, LDS_TOTAL);
        hipOccupancyMaxActiveBlocksPerMultiprocessor(&per_cu, (const void*)hybrid_megakernel, 512, LDS_TOTAL);
        if (per_cu < 1) per_cu = 1;
        grid_blocks = cus * 1;
        (void)hipGetLastError();
    }
    if (grid_blocks < 0) return;
    Params P{};
    for (int i = 0; i < 38; ++i) P.in[i] = (const float*)d_in[i];
    P.out = (float*)d_out; P.ws = (unsigned char*)d_ws;
    (void)hipMemsetAsync((unsigned char*)d_ws + O_BAR, 0, 16384, stream);
    void* args[] = {&P};
    hipError_t e = hipLaunchCooperativeKernel((const void*)hybrid_megakernel, dim3(grid_blocks), dim3(512), args, LDS_TOTAL, stream);
    if (e != hipSuccess) fprintf(stderr, "cooperative launch failed: %s (grid %d)\n", hipGetErrorString(e), grid_blocks);
}
#endif
```
